# Optimizing an MI355X kernel written in HIP

```python
import jax, jax.numpy as jnp
from jax import lax
import numpy as np

D_MODEL = 2048
BATCH = 4
SEQ = 4096
DEPTH = 4

CTX_LEN = 256
GRID_W = 64
N_MIXERS = 2
N_HEADS = 16
HEAD_DIM = D_MODEL // N_HEADS
WIN_ROWS = 8
WIN_COLS = 16
Q_COLS = 16
K_COLS = Q_COLS + WIN_COLS
POOL_WINDOWS = (2, 4, 8, 16)
N_POOL_GROUPS = len(POOL_WINDOWS)
POOL_GROUP = D_MODEL // N_POOL_GROUPS
D_FF = -(-8 * D_MODEL // (3 * 256)) * 256
N_ADA = 6
LN_EPS = 1e-5
DN_ALPHA = (2 * DEPTH) ** 0.25
DN_BETA = (8 * DEPTH) ** -0.25
N_NA_LAYERS = len([i for i in range(DEPTH) if i % N_MIXERS == 0])
N_POOL_LAYERS = DEPTH - N_NA_LAYERS

kernel_name = "hybrid_natten_pool_deepnorm_dit"


def layer_norm(x, g, b):
    xf = x.astype(jnp.float32)
    mu = xf.mean(-1, keepdims=True)
    var = jnp.square(xf - mu).mean(-1, keepdims=True)
    y = (xf - mu) * lax.rsqrt(var + LN_EPS) * g.astype(jnp.float32) + b.astype(jnp.float32)
    return y.astype(x.dtype)


def ada_params(cond, w, b):
    return jnp.split(jax.nn.silu(cond) @ w + b, N_ADA, axis=-1)


def modulate(x, shift, scale):
    return x * (1 + scale) + shift


def split_heads(t):
    return t.reshape(*t.shape[:-1], N_HEADS, HEAD_DIM)


def neighbourhood_attention(q, k, v, k_ctx, v_ctx, rpb):
    B, L = q.shape[0], q.shape[1]
    rows = L // GRID_W
    kr = min(WIN_ROWS, rows)
    n_cb = GRID_W // Q_COLS
    scale = HEAD_DIM ** -0.5
    q_col = np.arange(GRID_W).reshape(n_cb, Q_COLS)
    win_start = np.clip(q_col - WIN_COLS // 2, 0, GRID_W - WIN_COLS)
    band_start = np.clip(np.arange(n_cb) * Q_COLS - WIN_COLS // 2, 0, GRID_W - K_COLS)
    key_col_np = band_start[:, None] + np.arange(K_COLS)
    kc = key_col_np[:, None, :]
    col_ok = (kc >= win_start[:, :, None]) & (kc < win_start[:, :, None] + WIN_COLS)
    col_ok = jnp.asarray(col_ok)[:, :, None, :]
    dc_idx = jnp.asarray(np.clip(kc - q_col[:, :, None] + WIN_COLS - 1, 0, 2 * WIN_COLS - 2))[:, :, None, :]
    key_col = jnp.asarray(key_col_np)
    qg = q.reshape(B, rows, GRID_W, N_HEADS, HEAD_DIM)
    kg = k.reshape(B, rows, GRID_W, N_HEADS, HEAD_DIM)
    vg = v.reshape(B, rows, GRID_W, N_HEADS, HEAD_DIM)
    n_win = kr * K_COLS

    def row_block(r):
        r0 = jnp.clip(r - kr // 2, 0, rows - kr)
        q_blk = lax.dynamic_index_in_dim(qg, r, axis=1, keepdims=False).reshape(B, n_cb, Q_COLS, N_HEADS, HEAD_DIM)
        k_blk = lax.dynamic_slice_in_dim(kg, r0, kr, axis=1)[:, :, key_col]
        v_blk = lax.dynamic_slice_in_dim(vg, r0, kr, axis=1)[:, :, key_col]
        dr_idx = (r0 + jnp.arange(kr) - r + WIN_ROWS - 1)[None, None, :, None]
        bias = rpb[:, dr_idx, dc_idx]
        s_win = jnp.einsum('bjqhd,brjkhd->bhjqrk', q_blk, k_blk).astype(jnp.float32) * scale
        s_win = jnp.where(col_ok, s_win + bias.astype(jnp.float32), -jnp.inf)
        s_win = s_win.reshape(B, N_HEADS, n_cb, Q_COLS, n_win)
        s_ctx = jnp.einsum('bjqhd,bchd->bhjqc', q_blk, k_ctx).astype(jnp.float32) * scale
        p = jax.nn.softmax(jnp.concatenate([s_win, s_ctx], axis=-1), axis=-1).astype(v.dtype)
        p_win = p[..., :n_win].reshape(B, N_HEADS, n_cb, Q_COLS, kr, K_COLS)
        p_ctx = p[..., n_win:]
        o = (jnp.einsum('bhjqrk,brjkhd->bjqhd', p_win, v_blk)
             + jnp.einsum('bhjqc,bchd->bjqhd', p_ctx, v_ctx))
        return o.reshape(B, GRID_W, D_MODEL)

    o = lax.map(row_block, jnp.arange(rows))
    return jnp.moveaxis(o, 0, 1).reshape(B, L, D_MODEL)


def context_attention(q_ctx, k_ctx, v_ctx):
    B, C = q_ctx.shape[0], q_ctx.shape[1]
    s = jnp.einsum('bqhd,bkhd->bhqk', q_ctx, k_ctx).astype(jnp.float32) * HEAD_DIM ** -0.5
    p = jax.nn.softmax(s, axis=-1).astype(v_ctx.dtype)
    return jnp.einsum('bhqk,bkhd->bqhd', p, v_ctx).reshape(B, C, D_MODEL)


def multiscale_pool(h, w_pool, scale):
    B, L, _ = h.shape
    hf = h.astype(jnp.float32)
    csum = jnp.concatenate([jnp.zeros_like(hf[:, :1]), lax.cumsum(hf, axis=1)], axis=1)
    t = np.arange(L)
    groups = []
    for g, w in enumerate(POOL_WINDOWS):
        lo = np.clip(t - w // 2, 0, L)
        hi = np.clip(t - w // 2 + w, 0, L)
        sl = slice(g * POOL_GROUP, (g + 1) * POOL_GROUP)
        cg = csum[..., sl]
        mean = (cg[:, hi] - cg[:, lo]) / jnp.asarray(hi - lo, dtype=jnp.float32)[:, None]
        groups.append(mean - hf[..., sl])
    pooled = jnp.stack(groups, axis=2).astype(h.dtype)
    y = jnp.einsum('blgc,gcd->blgd', pooled, w_pool).reshape(B, L, D_MODEL)
    return y * scale


def swiglu(h, w_in, w_out):
    gate, up = jnp.split(h @ w_in, 2, axis=-1)
    return (jax.nn.silu(gate) * up) @ w_out


def setup_inputs(seed: int = 0) -> dict:
    key = jax.random.key(seed)
    ks = jax.random.split(key, 20)
    f32 = jnp.float32

    def nrm(k, shape, s):
        return jax.random.normal(k, shape, f32) * s

    v_scale = jnp.concatenate([jnp.ones((2 * D_MODEL,), f32), jnp.full((D_MODEL,), DN_BETA, f32)])
    return {
        "x": nrm(ks[0], (BATCH, SEQ, D_MODEL), 1.0),
        "c": nrm(ks[1], (BATCH, D_MODEL), 1.0),
        "ctx": nrm(ks[2], (BATCH, CTX_LEN, D_MODEL), 1.0),
        "c_ctx": nrm(ks[3], (D_MODEL,), 1.0),
        "ada_w": nrm(ks[4], (DEPTH, D_MODEL, N_ADA * D_MODEL), 0.5 * D_MODEL ** -0.5),
        "ada_b": nrm(ks[5], (DEPTH, N_ADA * D_MODEL), 0.02),
        "ln_mix_g": 1.0 + nrm(ks[6], (DEPTH, D_MODEL), 0.02),
        "ln_mix_b": nrm(ks[7], (DEPTH, D_MODEL), 0.02),
        "ln_ffn_g": 1.0 + nrm(ks[8], (DEPTH, D_MODEL), 0.02),
        "ln_ffn_b": nrm(ks[9], (DEPTH, D_MODEL), 0.02),
        "na_w_qkv": nrm(ks[10], (N_NA_LAYERS, D_MODEL, 3 * D_MODEL), D_MODEL ** -0.5) * v_scale,
        "na_w_o": nrm(ks[11], (N_NA_LAYERS, D_MODEL, D_MODEL), DN_BETA * D_MODEL ** -0.5),
        "na_rpb": nrm(ks[12], (N_NA_LAYERS, N_HEADS, 2 * WIN_ROWS - 1, 2 * WIN_COLS - 1), 0.1),
        "pool_w": nrm(ks[13], (N_POOL_LAYERS, N_POOL_GROUPS, POOL_GROUP, POOL_GROUP), DN_BETA * POOL_GROUP ** -0.5),
        "pool_scale": 1.0 + nrm(ks[14], (N_POOL_LAYERS, D_MODEL), 0.05),
        "ffn_w_in": nrm(ks[15], (DEPTH, D_MODEL, 2 * D_FF), D_MODEL ** -0.5),
        "ffn_w_out": nrm(ks[16], (DEPTH, D_FF, D_MODEL), DN_BETA * D_FF ** -0.5),
    }


def reference(x, c, ctx, c_ctx, ada_w, ada_b, ln_mix_g, ln_mix_b, ln_ffn_g, ln_ffn_b,
              na_w_qkv, na_w_o, na_rpb, pool_w, pool_scale, ffn_w_in, ffn_w_out):
    last_na = max(i for i in range(DEPTH) if i % N_MIXERS == 0)
    xc = ctx
    for i in range(DEPTH):
        use_na = i % N_MIXERS == 0
        j = i // N_MIXERS
        update_ctx = i < last_na
        sh1, sc1, g1, sh2, sc2, g2 = [m[:, None, :] for m in ada_params(c, ada_w[i], ada_b[i])]
        h = modulate(x, sh1, sc1)
        if update_ctx or use_na:
            csh1, csc1, cg1, csh2, csc2, cg2 = ada_params(c_ctx, ada_w[i], ada_b[i])
            hc = modulate(xc, csh1, csc1)
        if use_na:
            w_qkv = na_w_qkv[j]
            q, k, v = [split_heads(t) for t in jnp.split(h @ w_qkv, 3, axis=-1)]
            k_c, v_c = [split_heads(t) for t in jnp.split(hc @ w_qkv[:, D_MODEL:], 2, axis=-1)]
            y = neighbourhood_attention(q, k, v, k_c, v_c, na_rpb[j]) @ na_w_o[j]
            if update_ctx:
                q_c = split_heads(hc @ w_qkv[:, :D_MODEL])
                yc = context_attention(q_c, k_c, v_c) @ na_w_o[j]
        else:
            y = multiscale_pool(h, pool_w[j], pool_scale[j])
            if update_ctx:
                yc = multiscale_pool(hc, pool_w[j], pool_scale[j])
        x = layer_norm(DN_ALPHA * x + g1 * y, ln_mix_g[i], ln_mix_b[i])
        x = layer_norm(DN_ALPHA * x + g2 * swiglu(modulate(x, sh2, sc2), ffn_w_in[i], ffn_w_out[i]),
                       ln_ffn_g[i], ln_ffn_b[i])
        if update_ctx:
            xc = layer_norm(DN_ALPHA * xc + cg1 * yc, ln_mix_g[i], ln_mix_b[i])
            xc = layer_norm(DN_ALPHA * xc + cg2 * swiglu(modulate(xc, csh2, csc2), ffn_w_in[i], ffn_w_out[i]),
                            ln_ffn_g[i], ln_ffn_b[i])
    return x
```

```cpp
#include <hip/hip_runtime.h>
#include <cstdio>
#include <cstdint>

#ifndef MK_ONE_LAUNCH
#define MK_ONE_LAUNCH 0
#endif

namespace pg8 {
#define PG8_LAS __attribute__((address_space(3)))
typedef unsigned short bf16_t;
typedef short bf16x8 __attribute__((ext_vector_type(8)));
typedef float f32x4 __attribute__((ext_vector_type(4)));
typedef unsigned u32x4 __attribute__((ext_vector_type(4)));
constexpr int BM = 256, BK = 64, HALF = 128, HTB = HALF * BK * 2  , STAGE_BYTES = 8 * HTB, NXCD = 8, WGM = 8;

__host__ __device__ __forceinline__ int lds_byte(int r, int c) { const int st = (r >> 4) * 2 + (c >> 5), rr = r & 15, cc = c & 31, ob = rr * 64 + cc * 2; return st * 1024 + (ob ^ (((ob >> 9) & 1) << 5)); }
__host__ __device__ __forceinline__ void stage_rc(int b, int& R, int& C) { const int st = b / 1024, sb = b % 1024, swz = sb ^ (((sb >> 9) & 1) << 5); R = (st >> 1) * 16 + swz / 64; C = (st & 1) * 32 + (swz % 64) / 2; }
__host__ __device__ __forceinline__ int perm32(int rho) { const int n = rho >> 4, i = rho & 15; return 8 * (i >> 2) + 4 * n + (i & 3); }

__device__ __forceinline__ int opaque_v(int v) { asm volatile("" : "+v"(v)); return v; }
struct Unit { int pm, pn; };
struct Gemm { const bf16_t* A; const bf16_t* Bt; int M, N, K, lda, ldb, grp_pn, grp_k; };

struct StaticOrder {
    int nM, nN, nwg, G, c;
    __host__ __device__ void init(int M, int N, int G_, int c_) { nM = M / BM; nN = N / BM; nwg = nM * nN; G = G_; c = c_; }
    __host__ __device__ bool next(int i, Unit& u) const {
        const long L = (long)i * G + c; if (L >= nwg) return false;
        int wgid = (int)L; { const int q = nwg / NXCD, r = nwg % NXCD, xcd = wgid % NXCD, off = wgid / NXCD; wgid = (xcd < r ? xcd * (q + 1) : r * (q + 1) + (xcd - r) * q) + off; }
        const int nig = WGM * nN, gid = wgid / nig, fm = gid * WGM, gsz = (nM - fm) < WGM ? (nM - fm) : WGM;
        u.pm = fm + ((wgid % nig) % gsz); u.pn = (wgid % nig) / gsz; return true;
    }
    __device__ __forceinline__ void a_ready(const Unit&) const {}
    __device__ __forceinline__ void done(const Unit&) const {}
};

__device__ __forceinline__ unsigned cvt_pk_bf16(float lo, float hi) { unsigned r; asm volatile("v_cvt_pk_bf16_f32 %0, %1, %2" : "=v"(r) : "v"(lo), "v"(hi)); return r; }

struct EpiBf16 {
    static constexpr bool PERM = true, AFTER_DRAIN = false;
    bf16_t* O; int ldc;
    __device__ __forceinline__ void operator()(const f32x4 (&acc)[2][2][4][2], const Unit& u, int wr, int wc, int fr, int fq) const {
        const int row0 = u.pm * BM + wr * 64 + fr; const int col0 = u.pn * BM + wc * 32 + 8 * fq;
#pragma unroll
        for (int ai = 0; ai < 2; ++ai)
#pragma unroll
            for (int m = 0; m < 4; ++m) { bf16_t* rowp = O + (size_t)(row0 + ai * HALF + m * 16) * ldc + col0;
#pragma unroll
                for (int bj = 0; bj < 2; ++bj) { const f32x4 v0 = acc[ai][bj][m][0], v1 = acc[ai][bj][m][1];
                    u32x4 w; w.x = cvt_pk_bf16(v0[0], v0[1]); w.y = cvt_pk_bf16(v0[2], v0[3]); w.z = cvt_pk_bf16(v1[0], v1[1]); w.w = cvt_pk_bf16(v1[2], v1[3]);
                    *(u32x4*)(rowp + bj * HALF) = w; } }
    }
};
struct EpiSwiGLU {
    static constexpr bool PERM = true, AFTER_DRAIN = false;
    bf16_t* O; int ldc;
    __device__ __forceinline__ float act(float g, float u) const { return g * u * __builtin_amdgcn_rcpf(1.0f + __builtin_amdgcn_exp2f(g * -1.44269504089f)); }
    __device__ __forceinline__ void operator()(const f32x4 (&acc)[2][2][4][2], const Unit& u, int wr, int wc, int fr, int fq) const {
        const int row0 = u.pm * BM + wr * 64 + fr; const int col0 = u.pn * HALF + wc * 32 + 8 * fq;
#pragma unroll
        for (int ai = 0; ai < 2; ++ai)
#pragma unroll
            for (int m = 0; m < 4; ++m) { bf16_t* rowp = O + (size_t)(row0 + ai * HALF + m * 16) * ldc + col0;
                const f32x4 g0 = acc[ai][0][m][0], g1 = acc[ai][0][m][1], u0 = acc[ai][1][m][0], u1 = acc[ai][1][m][1];
                u32x4 w; w.x = cvt_pk_bf16(act(g0[0], u0[0]), act(g0[1], u0[1])); w.y = cvt_pk_bf16(act(g0[2], u0[2]), act(g0[3], u0[3]));
                w.z = cvt_pk_bf16(act(g1[0], u1[0]), act(g1[1], u1[1])); w.w = cvt_pk_bf16(act(g1[2], u1[2]), act(g1[3], u1[3]));
                *(u32x4*)rowp = w; }
    }
};
struct EpiRes {
    static constexpr bool PERM = false, AFTER_DRAIN = false;
    float* X; int ldx; const float* gate; int gate_stride; const float* colscale; float alpha;
    __device__ __forceinline__ void operator()(const f32x4 (&acc)[2][2][4][2], const Unit& u, int wr, int wc, int fr, int fq) const {
        const int row0 = u.pm * BM + wr * 64 + fr, col0 = u.pn * BM + wc * 32 + 4 * fq;
        const int cond = u.pm < 64 ? (u.pm >> 4) : 4;
        const float* gp = gate + (size_t)cond * gate_stride + col0;
        f32x4 gv[2][2];
#pragma unroll
        for (int bj = 0; bj < 2; ++bj)
#pragma unroll
            for (int n = 0; n < 2; ++n) { gv[bj][n] = *(const f32x4*)(gp + bj * HALF + n * 16); if (colscale) gv[bj][n] = gv[bj][n] * *(const f32x4*)(colscale + col0 + bj * HALF + n * 16); }
#pragma unroll
        for (int ai = 0; ai < 2; ++ai)
#pragma unroll
            for (int m = 0; m < 4; ++m) { float* rowp = X + (size_t)(row0 + ai * HALF + m * 16) * ldx + col0;
#pragma unroll
                for (int bj = 0; bj < 2; ++bj)
#pragma unroll
                    for (int n = 0; n < 2; ++n) { const f32x4 xv = *(const f32x4*)(rowp + bj * HALF + n * 16); *(f32x4*)(rowp + bj * HALF + n * 16) = xv * alpha + gv[bj][n] * acc[ai][bj][m][n]; }
                asm volatile("" ::: "memory"); }
    }
};

template <class Epi, class Sched, bool ALIGN_EPI = false, bool SP2 = false>
__device__ __forceinline__ void gemm_phase(PG8_LAS unsigned char* lds, const Gemm g, const Sched& S, const Epi& E) {
    const int tid = opaque_v(threadIdx.x), wid = __builtin_amdgcn_readfirstlane(tid >> 6), lane = tid & 63, wr = wid >> 2, wc = wid & 3, fr = lane & 15, fq = lane >> 4;
    const int K = g.K, nt = K / BK;
    unsigned voffA[2], voffB[2];
#pragma unroll
    for (int i = 0; i < 2; ++i) { int R, C; stage_rc(tid * 16 + i * 8192, R, C); const int Rb = Epi::PERM ? ((R & ~31) + perm32(R & 31)) : R;
        voffA[i] = (unsigned)(R * g.lda + C) * 2u; voffB[i] = (unsigned)(Rb * g.ldb + C) * 2u; }
    const size_t kstep = (size_t)(BK * 2);
    const size_t hstepA = (size_t)HALF * g.lda * 2, hstepB = (size_t)HALF * g.ldb * 2;
    const size_t tstepA = 2 * hstepA, tstepB = 2 * hstepB;
    const unsigned ldsw = (unsigned)wid * 1024u;
    const int aoff = lds_byte(wr * 64 + fr, fq * 8), boff = lds_byte(wc * 32 + fr, fq * 8);
#define PG8_SA(b, h) (((b) * 2 + (h)) * HTB)
#define PG8_SB(b, h) ((4 + (b) * 2 + (h)) * HTB)
#define PG8_STAGE(bufoff, gbase, voff) do { _Pragma("unroll") for (int _i = 0; _i < 2; ++_i) \
        __builtin_amdgcn_global_load_lds((const unsigned*)((const char*)(gbase) + (voff)[_i]), (PG8_LAS unsigned*)(lds + (bufoff) + ldsw + _i * 8192), 16, 0, 0); } while (0)
#define PG8_LDA(dst, b, h) do { _Pragma("unroll") for (int m = 0; m < 4; ++m) _Pragma("unroll") for (int k = 0; k < 2; ++k) dst[m][k] = *(const PG8_LAS bf16x8*)(lds + PG8_SA(b, h) + aoff + m * 2048 + k * 1024); } while (0)
#define PG8_LDB(dst, b, h) do { _Pragma("unroll") for (int n = 0; n < 2; ++n) _Pragma("unroll") for (int k = 0; k < 2; ++k) dst[n][k] = *(const PG8_LAS bf16x8*)(lds + PG8_SB(b, h) + boff + n * 2048 + k * 1024); } while (0)
#define PG8_MMA(ai, bj, At, Bt) do { __builtin_amdgcn_s_setprio(1); _Pragma("unroll") for (int m = 0; m < 4; ++m) _Pragma("unroll") for (int n = 0; n < 2; ++n) _Pragma("unroll") for (int k = 0; k < 2; ++k) \
        acc[ai][bj][m][n] = __builtin_amdgcn_mfma_f32_16x16x32_bf16(Bt[n][k], At[m][k], acc[ai][bj][m][n], 0, 0, 0); __builtin_amdgcn_s_setprio(0); } while (0)
#define PG8_WAIT_V(n) asm volatile("s_waitcnt vmcnt(" #n ")" ::: "memory")
#define PG8_WAIT_L(n) asm volatile("s_waitcnt lgkmcnt(" #n ")" ::: "memory")
#define PG8_BAR __builtin_amdgcn_s_barrier()
#define PG8_SCHED __builtin_amdgcn_sched_barrier(0)
#define PG8_AOF(u) ((size_t)(u).pm * tstepA + (g.grp_pn ? (size_t)((u).pn / g.grp_pn) * (size_t)g.grp_k * 2 : (size_t)0))
    Unit cur, nxt; int ui = 0;
    if (!S.next(0, cur)) return;
    f32x4 acc[2][2][4][2];
#pragma unroll
    for (int a = 0; a < 2; ++a)
#pragma unroll
        for (int b = 0; b < 2; ++b)
#pragma unroll
            for (int m = 0; m < 4; ++m)
#pragma unroll
                for (int n = 0; n < 2; ++n) acc[a][b][m][n] = (f32x4){0.f, 0.f, 0.f, 0.f};
    bf16x8 At[4][2], B0[2][2], B1[2][2];
    const char* cA = (const char*)g.A + PG8_AOF(cur); const char* cB = (const char*)g.Bt + (size_t)cur.pn * tstepB;
    S.a_ready(cur);
    if constexpr (SP2) {
        PG8_STAGE(PG8_SB(0, 0), cB, voffB); PG8_STAGE(PG8_SB(0, 1), cB + hstepB, voffB); PG8_STAGE(PG8_SA(0, 0), cA, voffA); PG8_STAGE(PG8_SA(0, 1), cA + hstepA, voffA);
        if (wr == 1) PG8_BAR;
        PG8_WAIT_V(2); PG8_BAR;
        PG8_STAGE(PG8_SB(1, 0), cB + kstep, voffB); PG8_STAGE(PG8_SA(1, 0), cA + kstep, voffA); PG8_STAGE(PG8_SB(1, 1), cB + hstepB + kstep, voffB);
        PG8_WAIT_V(6); PG8_BAR;
    } else {
        PG8_STAGE(PG8_SB(0, 0), cB, voffB); PG8_STAGE(PG8_SA(0, 0), cA, voffA); PG8_STAGE(PG8_SB(0, 1), cB + hstepB, voffB); PG8_STAGE(PG8_SA(0, 1), cA + hstepA, voffA);
        if (wr == 1) PG8_BAR;
        PG8_WAIT_V(4); PG8_BAR;
        PG8_STAGE(PG8_SB(1, 0), cB + kstep, voffB); PG8_STAGE(PG8_SA(1, 0), cA + kstep, voffA); PG8_STAGE(PG8_SB(1, 1), cB + hstepB + kstep, voffB);
        PG8_WAIT_V(6); PG8_BAR;
    }
    for (;;) {
        const bool has_next = S.next(ui + 1, nxt);
        const char* nA = has_next ? (const char*)g.A + PG8_AOF(nxt) : cA; const char* nB = has_next ? (const char*)g.Bt + (size_t)nxt.pn * tstepB : cB;
        for (int t = 0; t < nt; t += 2) {
            const bool last = (t == nt - 2);
            const char* a1 = cA + (size_t)(t + 1) * kstep;
            const char* a2 = last ? nA : cA + (size_t)(t + 2) * kstep; const char* b2 = last ? nB : cB + (size_t)(t + 2) * kstep;
            const char* a3 = a2 + kstep; const char* b3 = b2 + kstep;
            if (last && has_next) S.a_ready(nxt);
            if constexpr (SP2) {
            PG8_LDB(B0, 0, 0); PG8_LDB(B1, 0, 1); PG8_SCHED; PG8_LDA(At, 0, 0); PG8_STAGE(PG8_SA(1, 1), a1 + hstepA, voffA);
            PG8_WAIT_V(8); PG8_WAIT_L(0); PG8_BAR; PG8_MMA(0, 0, At, B0); PG8_MMA(0, 1, At, B1); PG8_BAR; PG8_SCHED;
            PG8_LDA(At, 0, 1); PG8_STAGE(PG8_SB(0, 0), b2, voffB); PG8_STAGE(PG8_SB(0, 1), b2 + hstepB, voffB); PG8_STAGE(PG8_SA(0, 0), a2, voffA);
            PG8_WAIT_V(8); PG8_WAIT_L(0); PG8_BAR; PG8_MMA(1, 0, At, B0); PG8_MMA(1, 1, At, B1); PG8_BAR; PG8_SCHED;
            PG8_LDB(B0, 1, 0); PG8_LDB(B1, 1, 1); PG8_SCHED; PG8_LDA(At, 1, 0); PG8_STAGE(PG8_SA(0, 1), a2 + hstepA, voffA);
            PG8_WAIT_V(8); PG8_WAIT_L(0); PG8_BAR; PG8_MMA(0, 0, At, B0); PG8_MMA(0, 1, At, B1); PG8_BAR; PG8_SCHED;
            PG8_LDA(At, 1, 1); PG8_STAGE(PG8_SB(1, 0), b3, voffB); PG8_STAGE(PG8_SB(1, 1), b3 + hstepB, voffB); PG8_STAGE(PG8_SA(1, 0), a3, voffA);
            PG8_WAIT_V(8); PG8_WAIT_L(0); PG8_BAR; PG8_MMA(1, 0, At, B0); PG8_MMA(1, 1, At, B1); PG8_BAR; PG8_SCHED;
            } else {
            PG8_LDB(B0, 0, 0); PG8_SCHED; PG8_LDA(At, 0, 0); PG8_STAGE(PG8_SA(1, 1), a1 + hstepA, voffA);
            PG8_WAIT_L(8); PG8_BAR; PG8_WAIT_L(0); PG8_MMA(0, 0, At, B0); PG8_BAR; PG8_SCHED;
            PG8_LDB(B1, 0, 1); PG8_STAGE(PG8_SB(0, 0), b2, voffB);
            PG8_BAR; PG8_WAIT_L(0); PG8_MMA(0, 1, At, B1); PG8_BAR;
            PG8_LDA(At, 0, 1); PG8_STAGE(PG8_SA(0, 0), a2, voffA);
            PG8_BAR; PG8_WAIT_L(0); PG8_MMA(1, 0, At, B0); PG8_BAR; PG8_SCHED;
            PG8_STAGE(PG8_SB(0, 1), b2 + hstepB, voffB);
            PG8_WAIT_V(6); PG8_BAR; PG8_MMA(1, 1, At, B1); PG8_BAR;
            PG8_LDB(B0, 1, 0); PG8_SCHED; PG8_LDA(At, 1, 0); PG8_STAGE(PG8_SA(0, 1), a2 + hstepA, voffA);
            PG8_WAIT_L(8); PG8_BAR; PG8_WAIT_L(0); PG8_MMA(0, 0, At, B0); PG8_BAR; PG8_SCHED;
            PG8_LDB(B1, 1, 1); PG8_STAGE(PG8_SB(1, 0), b3, voffB);
            PG8_BAR; PG8_WAIT_L(0); PG8_MMA(0, 1, At, B1); PG8_BAR;
            PG8_LDA(At, 1, 1); PG8_STAGE(PG8_SA(1, 0), a3, voffA);
            PG8_BAR; PG8_WAIT_L(0); PG8_MMA(1, 0, At, B0); PG8_BAR; PG8_SCHED;
            PG8_STAGE(PG8_SB(1, 1), b3 + hstepB, voffB);
            PG8_WAIT_V(6); PG8_BAR; PG8_MMA(1, 1, At, B1); PG8_BAR;
            }
        }
        if constexpr (ALIGN_EPI) { if (wr == 0) PG8_BAR; }
        if constexpr (!Epi::AFTER_DRAIN) { E(acc, cur, wr, wc, fr, fq); S.done(cur); }
        if (!has_next) break;
#pragma unroll
        for (int a = 0; a < 2; ++a)
#pragma unroll
            for (int b = 0; b < 2; ++b)
#pragma unroll
                for (int m = 0; m < 4; ++m)
#pragma unroll
                    for (int n = 0; n < 2; ++n) acc[a][b][m][n] = (f32x4){0.f, 0.f, 0.f, 0.f};
        cur = nxt; cA = nA; cB = nB; ++ui;
        if constexpr (ALIGN_EPI) { if (wr == 1) PG8_BAR; }
    }
    PG8_WAIT_V(0);
    if constexpr (!ALIGN_EPI) { if (wr == 0) PG8_BAR; }
    PG8_BAR;
#undef PG8_AOF
#undef PG8_SA
#undef PG8_SB
#undef PG8_STAGE
#undef PG8_LDA
#undef PG8_LDB
#undef PG8_MMA
#undef PG8_WAIT_V
#undef PG8_WAIT_L
#undef PG8_BAR
#undef PG8_SCHED
}
}

constexpr int NWAVES = 8;
constexpr int D = 2048, BATCH = 4, SEQ = 4096, DEPTH = 4, CTXL = 256, GRIDW = 64, NH = 16, HD = 128;
constexpr int DFF = 5632, NADA = 6;
constexpr int ML = BATCH * SEQ;
constexpr int MC = BATCH * CTXL;
constexpr int MR = ML + MC;
constexpr int NCOND = BATCH + 1;
constexpr int ADAW = NADA * D;
constexpr float LN_EPS = 1e-5f;
constexpr float DN_ALPHA = 1.6817928305074290f;
constexpr float ATT_SCALE = 0.08838834764831845f;
constexpr int KSPLIT = 32;

constexpr size_t MiB = 1u << 20;
constexpr size_t WS_CTL = 0, CTL_ZERO_BYTES = 1 * MiB;
constexpr size_t WS_ADA = 1 * MiB;
constexpr size_t WS_PART = 2 * MiB;
constexpr size_t WS_WQKV = 34 * MiB;
constexpr size_t WS_WO = 82 * MiB;
constexpr size_t WS_WPOOL = 98 * MiB;
constexpr size_t WS_WIN = 102 * MiB;
constexpr size_t WS_WOUT = 278 * MiB;
constexpr size_t WS_X = 366 * MiB;
constexpr size_t WS_H = 502 * MiB;
constexpr size_t WS_QKV = 570 * MiB;
constexpr size_t WS_O = 774 * MiB;
constexpr size_t WS_ACT = 842 * MiB;
constexpr size_t WS_END = 1030 * MiB;
constexpr int CW_TMO = 0, CW_CODE = 1;
constexpr int CW_BAR = 4096;

constexpr int RING_OFF = 0, RING_BYTES = 131072;
constexpr int LDSCTL_OFF = RING_BYTES, MISC_OFF = LDSCTL_OFF + 320;
constexpr int LDS_BYTES = 147456;

#define GAS __attribute__((address_space(1)))
#define LAS __attribute__((address_space(3)))
typedef unsigned short bf16;
typedef unsigned v4u __attribute__((ext_vector_type(4)));
typedef unsigned v2u __attribute__((ext_vector_type(2)));
typedef float f32x4 __attribute__((ext_vector_type(4)));
typedef GAS unsigned gu32;
#define RLX_AGENT __ATOMIC_RELAXED, __HIP_MEMORY_SCOPE_AGENT
#define LDS_WAIT() asm volatile("s_waitcnt lgkmcnt(0)" ::: "memory")
#define VM_WAIT() asm volatile("s_waitcnt vmcnt(0)" ::: "memory")
__device__ __forceinline__ unsigned f2bf(float f) { unsigned u = __builtin_bit_cast(unsigned, f); return (u + 0x7fffu + ((u >> 16) & 1u)) >> 16; }
__device__ __forceinline__ unsigned pk2(float lo, float hi) { return f2bf(lo) | (f2bf(hi) << 16); }
__device__ __forceinline__ float bf_lo(unsigned w) { return __builtin_bit_cast(float, w << 16); }
__device__ __forceinline__ float bf_hi(unsigned w) { return __builtin_bit_cast(float, w & 0xffff0000u); }

#define XB_TMO      128
#define XB_XCNT(j)  (256  + 64 * (j))
#define XB_XSUB(j)  (1280 + 64 * (j))
#define XB_XGEN(j)  (2304 + 64 * (j))
#define XB_TOP      3328
#define XB_TOPGEN   3392
#define XCD_BAR_WORDS 3456
#define XB_SPIN_CAP (1u << 18)

__device__ __forceinline__ unsigned xb_ld(unsigned* p)              { return __hip_atomic_load(p, __ATOMIC_RELAXED, __HIP_MEMORY_SCOPE_AGENT); }
__device__ __forceinline__ unsigned xb_add(unsigned* p, unsigned v) { return __hip_atomic_fetch_add(p, v, __ATOMIC_RELAXED, __HIP_MEMORY_SCOPE_AGENT); }
__device__ __forceinline__ unsigned xb_xcc_id() { return (unsigned)__builtin_amdgcn_s_getreg((3 << 11) | 20) & 0xFu; }
#define XB_SPIN(cond, bar) do { unsigned _sp = 0; while (cond) { __builtin_amdgcn_s_sleep(1); \
    if ((++_sp & 255u) == 0u) { if (xb_ld(&(bar)[XB_TMO])) break; if (_sp > XB_SPIN_CAP) { atomicAdd(&(bar)[XB_TMO], 1u); break; } } } } while (0)

struct XcdBarrier { unsigned* bar; unsigned x; volatile LAS unsigned* st; };

__device__ __forceinline__ XcdBarrier xcd_barrier_post(unsigned* bar, volatile LAS unsigned* st) {
    XcdBarrier b; b.bar = bar; b.x = xb_xcc_id(); b.st = st;
    if (threadIdx.x == 0) (void)xb_add(&bar[XB_XCNT(b.x)], 1u);
    return b;
}
__device__ __forceinline__ void xcd_barrier_complete(unsigned* bar, unsigned x, unsigned& nloc, unsigned& nx) {
    const unsigned G = gridDim.x * gridDim.y * gridDim.z;
    unsigned sum, cnt, mine, sp = 0u;
    for (;;) {
        sum = 0u; cnt = 0u; mine = 0u;
#pragma unroll
        for (unsigned j = 0; j < 16; ++j) { const unsigned c = xb_ld(&bar[XB_XCNT(j)]); sum += c; cnt += (c > 0u) ? 1u : 0u; mine = (j == x) ? c : mine; }
        if (sum == G) break;
        __builtin_amdgcn_s_sleep(1);
        if ((++sp & 255u) == 0u) { if (xb_ld(&bar[XB_TMO])) break; if (sp > XB_SPIN_CAP) { atomicAdd(&bar[XB_TMO], 1u); break; } }
    }
    nloc = mine > 0u ? mine : 1u; nx = cnt > 0u ? cnt : 1u;
}
__device__ __forceinline__ void xcd_barrier(const XcdBarrier& b) {
    asm volatile("s_waitcnt vmcnt(0)" ::: "memory");
    __syncthreads();
    if (threadIdx.x == 0) {
        unsigned* bar = b.bar;
        __builtin_amdgcn_s_waitcnt(0);
        unsigned nloc = b.st[0], nx = b.st[1];
        if (nloc == 0u) { xcd_barrier_complete(bar, b.x, nloc, nx); b.st[0] = nloc; b.st[1] = nx; }
        const unsigned old = xb_add(&bar[XB_XSUB(b.x)], 1u);
        const unsigned gen = old / nloc;
        if (old + 1u == (gen + 1u) * nloc) {
            __builtin_amdgcn_fence(__ATOMIC_RELEASE, "agent");
            asm volatile("s_waitcnt vmcnt(0)" ::: "memory");
            const unsigned og = xb_add(&bar[XB_TOP], 1u);
            const unsigned tg = og / nx;
            if (og + 1u == (tg + 1u) * nx) xb_add(&bar[XB_TOPGEN], 1u);
            else XB_SPIN(xb_ld(&bar[XB_TOPGEN]) == tg, bar);
            __builtin_amdgcn_fence(__ATOMIC_ACQUIRE, "agent");
            xb_add(&bar[XB_XGEN(b.x)], 1u);
            asm volatile("s_waitcnt vmcnt(0)" ::: "memory");
        } else {
            XB_SPIN(xb_ld(&bar[XB_XGEN(b.x)]) == gen, bar);
            __builtin_amdgcn_fence(__ATOMIC_ACQUIRE, "agent");
            asm volatile("s_waitcnt vmcnt(0)" ::: "memory");
        }
    }
    __syncthreads();
}

struct Args {
    const float *x, *c, *ctx, *c_ctx, *ada_w, *ada_b, *ln_mix_g, *ln_mix_b, *ln_ffn_g, *ln_ffn_b, *na_w_qkv, *na_w_o, *na_rpb, *pool_w, *pool_scale, *ffn_w_in, *ffn_w_out;
    float* out; unsigned char* ws; int ph_lo, ph_hi;
};
struct Frame {
    LAS unsigned char* lds;
    volatile LAS unsigned* MISC;
    gu32* ctl;
    int tid, lane, wave;
    int vcu, G;
};

__device__ __forceinline__ float wave_sum(float v) {
#pragma unroll
    for (int o = 1; o < 64; o <<= 1) v += __shfl_xor(v, o);
    return v;
}
__device__ __forceinline__ float silu_f(float v) { return v / (1.0f + __expf(-v)); }

__device__ __forceinline__ void transpose_item(const float* W, int N, bf16* WT, int ldt, int drow0, LAS float* scr, int k0, int n0, int lane) {
#pragma unroll 8
    for (int i = 0; i < 32; ++i) { const int kk = 2 * i + (lane >> 5); scr[kk * 33 + (lane & 31)] = W[(size_t)(k0 + kk) * N + n0 + (lane & 31)]; }
    LDS_WAIT(); asm volatile("" ::: "memory");
    const int c = lane & 7;
#pragma unroll
    for (int j = 0; j < 4; ++j) { const int n = (lane >> 3) + 8 * j; const LAS float* s = scr + (8 * c) * 33 + n;
        v4u o; o.x = pk2(s[0 * 33], s[1 * 33]); o.y = pk2(s[2 * 33], s[3 * 33]); o.z = pk2(s[4 * 33], s[5 * 33]); o.w = pk2(s[6 * 33], s[7 * 33]);
        *(GAS v4u*)(WT + (size_t)(drow0 + n) * ldt + k0 + 8 * c) = o; }
    LDS_WAIT(); asm volatile("" ::: "memory");
}

__device__ __forceinline__ void p_convert_weights(Frame F, const Args& a) {
    F.tid = pg8::opaque_v(F.tid); F.lane = F.tid & 63;
    LAS float* scr = (LAS float*)(F.lds + RING_OFF + F.wave * 16384);
    const int gw = F.vcu * NWAVES + F.wave, NGW = F.G * NWAVES;
    unsigned char* ws = a.ws;
    constexpr int I_QKV = (D / 64) * (3 * D / 32), I_O = (D / 64) * (D / 32), I_POOL = (512 / 64) * (512 / 32), I_IN = (D / 64) * (2 * DFF / 32), I_OUT = (DFF / 64) * (D / 32);
    constexpr int T_QKV = 2 * I_QKV, T_O = 2 * I_O, T_POOL = 8 * I_POOL, T_IN = 4 * I_IN, T_OUT = 4 * I_OUT;
    constexpr int NITEMS = T_QKV + T_O + T_POOL + T_IN + T_OUT;
    for (int it = gw; it < NITEMS; it += NGW) {
        int r = it;
        if (r < T_QKV) { const int j = r / I_QKV, q = r % I_QKV, nblk = 3 * D / 32, kb = q / nblk, nb = q % nblk;
            transpose_item(a.na_w_qkv + (size_t)j * D * 3 * D, 3 * D, (bf16*)(ws + WS_WQKV) + (size_t)j * 3 * D * D, D, 32 * nb, scr, 64 * kb, 32 * nb, F.lane); continue; } r -= T_QKV;
        if (r < T_O) { const int j = r / I_O, q = r % I_O, nblk = D / 32, kb = q / nblk, nb = q % nblk;
            transpose_item(a.na_w_o + (size_t)j * D * D, D, (bf16*)(ws + WS_WO) + (size_t)j * D * D, D, 32 * nb, scr, 64 * kb, 32 * nb, F.lane); continue; } r -= T_O;
        if (r < T_POOL) { const int jg = r / I_POOL, q = r % I_POOL, nblk = 512 / 32, kb = q / nblk, nb = q % nblk;
            transpose_item(a.pool_w + (size_t)jg * 512 * 512, 512, (bf16*)(ws + WS_WPOOL) + (size_t)(jg >> 2) * D * 512, 512, (jg & 3) * 512 + 32 * nb, scr, 64 * kb, 32 * nb, F.lane); continue; } r -= T_POOL;
        if (r < T_IN) { const int l = r / I_IN, q = r % I_IN, nblk = 2 * DFF / 32, kb = q / nblk, nb = q % nblk; const int n0 = 32 * nb, bj = n0 / DFF, jj = n0 % DFF;
            transpose_item(a.ffn_w_in + (size_t)l * D * 2 * DFF, 2 * DFF, (bf16*)(ws + WS_WIN) + (size_t)l * 2 * DFF * D, D, 256 * (jj / 128) + 128 * bj + (jj % 128), scr, 64 * kb, n0, F.lane); continue; } r -= T_IN;
        { const int l = r / I_OUT, q = r % I_OUT, nblk = D / 32, kb = q / nblk, nb = q % nblk;
            transpose_item(a.ffn_w_out + (size_t)l * DFF * D, D, (bf16*)(ws + WS_WOUT) + (size_t)l * D * DFF, DFF, 32 * nb, scr, 64 * kb, 32 * nb, F.lane); }
    }
}
__device__ __forceinline__ void p_copy_x(Frame F, const Args& a) {
    F.tid = pg8::opaque_v(F.tid); F.lane = F.tid & 63;
    float* X = (float*)(a.ws + WS_X);
    const size_t n4l = (size_t)ML * D / 4, n4c = (size_t)MC * D / 4, stride = (size_t)F.G * 512;
    const f32x4* s0 = (const f32x4*)a.x; const f32x4* s1 = (const f32x4*)a.ctx; f32x4* d = (f32x4*)X;
    for (size_t i = (size_t)F.vcu * 512 + F.tid; i < n4l + n4c; i += stride) d[i] = i < n4l ? s0[i] : s1[i - n4l];
}
__device__ __forceinline__ void p_ada_partial(Frame F, const Args& a) {
    F.tid = pg8::opaque_v(F.tid); F.lane = F.tid & 63;
    LAS float* sc = (LAS float*)(F.lds + RING_OFF);
    float* PART = (float*)(a.ws + WS_PART);
    constexpr int NCC = ADAW / 2048, NITEMS = DEPTH * NCC * KSPLIT;
    for (int it = F.vcu; it < NITEMS; it += F.G) {
        const int kc = it % KSPLIT, cc = (it / KSPLIT) % NCC, l = it / (KSPLIT * NCC);
        __syncthreads();
        if (F.tid < NCOND * 64) { const int i = F.tid >> 6, k = kc * 64 + (F.tid & 63); const float v = i < BATCH ? a.c[i * D + k] : a.c_ctx[k]; sc[F.tid] = silu_f(v); }
        __syncthreads();
        const float* wp = a.ada_w + ((size_t)l * D + kc * 64) * ADAW + cc * 2048 + 4 * F.tid;
        f32x4 acc[NCOND];
#pragma unroll
        for (int i = 0; i < NCOND; ++i) acc[i] = (f32x4){0.f, 0.f, 0.f, 0.f};
#pragma unroll 8
        for (int k = 0; k < 64; ++k) { const f32x4 w = *(const f32x4*)(wp + (size_t)k * ADAW);
#pragma unroll
            for (int i = 0; i < NCOND; ++i) acc[i] += w * sc[i * 64 + k]; }
#pragma unroll
        for (int i = 0; i < NCOND; ++i) *(f32x4*)(PART + (((size_t)kc * DEPTH + l) * NCOND + i) * ADAW + cc * 2048 + 4 * F.tid) = acc[i];
    }
}
__device__ __forceinline__ void p_ada_reduce(Frame F, const Args& a) {
    F.tid = pg8::opaque_v(F.tid); F.lane = F.tid & 63;
    const float* PART = (const float*)(a.ws + WS_PART); float* ADA = (float*)(a.ws + WS_ADA);
    constexpr int N4 = DEPTH * NCOND * ADAW / 4;
    for (int i = F.vcu * 512 + F.tid; i < N4; i += F.G * 512) {
        const int col4 = i % (ADAW / 4), l = i / (NCOND * ADAW / 4);
        f32x4 s = *(const f32x4*)(a.ada_b + (size_t)l * ADAW + 4 * col4);
        for (int kc = 0; kc < KSPLIT; ++kc) s += *(const f32x4*)(PART + (size_t)kc * DEPTH * NCOND * ADAW + 4 * (size_t)i);
        *(f32x4*)(ADA + 4 * (size_t)i) = s;
    }
}
__device__ __forceinline__ void p_modulate(Frame F, const Args& a, int nrows, const float* ada_l, int sh_off, int sc_off) {
    F.tid = pg8::opaque_v(F.tid); F.lane = F.tid & 63;
    const float* X = (const float*)(a.ws + WS_X); bf16* H = (bf16*)(a.ws + WS_H);
    const int gw = F.vcu * NWAVES + F.wave, NGW = F.G * NWAVES;
    for (int r = gw; r < nrows; r += NGW) {
        const int cond = r < ML ? r / SEQ : BATCH; const float* ap = ada_l + (size_t)cond * ADAW;
#pragma unroll
        for (int j = 0; j < 8; ++j) { const int col = 4 * F.lane + 256 * j; const f32x4 v = *(const f32x4*)(X + (size_t)r * D + col), sh = *(const f32x4*)(ap + sh_off + col), sc = *(const f32x4*)(ap + sc_off + col);
            const f32x4 h = v * (sc + 1.0f) + sh; v2u o; o.x = pk2(h[0], h[1]); o.y = pk2(h[2], h[3]); *(v2u*)(H + (size_t)r * D + col) = o; }
    }
}
__device__ __forceinline__ void p_layernorm(Frame F, const Args& a, int nrows, const float* g, const float* b, float* outp, const float* ada_n, int sh_off, int sc_off) {
    F.tid = pg8::opaque_v(F.tid); F.lane = F.tid & 63;
    float* X = (float*)(a.ws + WS_X); bf16* H = (bf16*)(a.ws + WS_H);
    const int gw = F.vcu * NWAVES + F.wave, NGW = F.G * NWAVES;
    for (int r = gw; r < nrows; r += NGW) {
        f32x4 v[8]; float s = 0.f;
#pragma unroll
        for (int j = 0; j < 8; ++j) { v[j] = *(const f32x4*)(X + (size_t)r * D + 4 * F.lane + 256 * j); s += (v[j][0] + v[j][1]) + (v[j][2] + v[j][3]); }
        const float mean = wave_sum(s) * (1.f / D); float s2 = 0.f;
#pragma unroll
        for (int j = 0; j < 8; ++j) { v[j] = v[j] - mean; s2 += (v[j][0] * v[j][0] + v[j][1] * v[j][1]) + (v[j][2] * v[j][2] + v[j][3] * v[j][3]); }
        const float rstd = 1.f / sqrtf(wave_sum(s2) * (1.f / D) + LN_EPS);
        const int cond = r < ML ? r / SEQ : BATCH;
#pragma unroll
        for (int j = 0; j < 8; ++j) { const int col = 4 * F.lane + 256 * j; const f32x4 y = v[j] * rstd * *(const f32x4*)(g + col) + *(const f32x4*)(b + col);
            *(f32x4*)(outp + (size_t)r * D + col) = y;
            if (ada_n) { const float* ap = ada_n + (size_t)cond * ADAW; const f32x4 h = y * (*(const f32x4*)(ap + sc_off + col) + 1.0f) + *(const f32x4*)(ap + sh_off + col);
                v2u o; o.x = pk2(h[0], h[1]); o.y = pk2(h[2], h[3]); *(v2u*)(H + (size_t)r * D + col) = o; } }
    }
}
__device__ __forceinline__ void p_pool(Frame F, const Args& a, int nrows, const float* ada_l) {
    F.tid = pg8::opaque_v(F.tid); F.lane = F.tid & 63;
    const float* X = (const float*)(a.ws + WS_X); bf16* P = (bf16*)(a.ws + WS_O);
    const int gw = F.vcu * NWAVES + F.wave, NGW = F.G * NWAVES;
    for (int r = gw; r < nrows; r += NGW) {
        int base, t, L, cond;
        if (r < ML) { cond = r / SEQ; base = cond * SEQ; t = r - base; L = SEQ; } else { const int q = r - ML; cond = BATCH; base = ML + (q / CTXL) * CTXL; t = q % CTXL; L = CTXL; }
        const float* ap = ada_l + (size_t)cond * ADAW + D;
#pragma unroll
        for (int j = 0; j < 8; ++j) { const int col = 4 * F.lane + 256 * j; const int w = 2 << (j >> 1);
            int lo = t - w / 2, hi = lo + w; lo = lo < 0 ? 0 : lo; hi = hi > L ? L : hi;
            f32x4 s = (f32x4){0.f, 0.f, 0.f, 0.f};
            for (int tt = lo; tt < hi; ++tt) s += *(const f32x4*)(X + (size_t)(base + tt) * D + col);
            const f32x4 xv = *(const f32x4*)(X + (size_t)r * D + col), sc = *(const f32x4*)(ap + col);
            const f32x4 p = (s * (1.0f / (float)(hi - lo)) - xv) * (sc + 1.0f);
            v2u o; o.x = pk2(p[0], p[1]); o.y = pk2(p[2], p[3]); *(v2u*)(P + (size_t)r * D + col) = o; }
    }
}

#define ATT_CHUNK(KEYPTR_EXPR, VALID_EXPR, BIAS_EXPR) do { \
    float s_[4]; v4u kk_[4][4]; \
    _Pragma("unroll") for (int e = 0; e < 4; ++e) { const bf16* kp_ = (KEYPTR_EXPR); _Pragma("unroll") for (int i = 0; i < 4; ++i) kk_[e][i] = *(const v4u*)(kp_ + 8 * i); } \
    _Pragma("unroll") for (int e = 0; e < 4; ++e) { float d_ = 0.f; \
        _Pragma("unroll") for (int i = 0; i < 4; ++i) { const v4u w_ = kk_[e][i]; \
            d_ += qf[8 * i + 0] * bf_lo(w_.x) + qf[8 * i + 1] * bf_hi(w_.x) + qf[8 * i + 2] * bf_lo(w_.y) + qf[8 * i + 3] * bf_hi(w_.y) \
                + qf[8 * i + 4] * bf_lo(w_.z) + qf[8 * i + 5] * bf_hi(w_.z) + qf[8 * i + 6] * bf_lo(w_.w) + qf[8 * i + 7] * bf_hi(w_.w); } \
        d_ += __shfl_xor(d_, 1); d_ += __shfl_xor(d_, 2); \
        s_[e] = (VALID_EXPR) ? d_ + (BIAS_EXPR) : -1e30f; } \
    const float cm_ = fmaxf(fmaxf(s_[0], s_[1]), fmaxf(s_[2], s_[3])); const float mn_ = fmaxf(m, cm_); const float rs_ = __expf(m - mn_); m = mn_; l *= rs_; \
    _Pragma("unroll") for (int i = 0; i < 32; ++i) acc[i] *= rs_; \
    _Pragma("unroll") for (int e = 0; e < 4; ++e) { const float p_ = (s_[e] > -1e29f) ? __expf(s_[e] - m) : 0.f; l += p_; const bf16* vp_ = (KEYPTR_EXPR) + D; \
        _Pragma("unroll") for (int i = 0; i < 4; ++i) { const v4u w_ = *(const v4u*)(vp_ + 8 * i); \
            acc[8 * i + 0] += p_ * bf_lo(w_.x); acc[8 * i + 1] += p_ * bf_hi(w_.x); acc[8 * i + 2] += p_ * bf_lo(w_.y); acc[8 * i + 3] += p_ * bf_hi(w_.y); \
            acc[8 * i + 4] += p_ * bf_lo(w_.z); acc[8 * i + 5] += p_ * bf_hi(w_.z); acc[8 * i + 6] += p_ * bf_lo(w_.w); acc[8 * i + 7] += p_ * bf_hi(w_.w); } } \
} while (0)

__device__ __forceinline__ void p_attention_valu(Frame F, const Args& a, const float* rpb, bool ctx_queries) {
    F.tid = pg8::opaque_v(F.tid); F.lane = F.tid & 63;
    const bf16* QKV = (const bf16*)(a.ws + WS_QKV); bf16* O = (bf16*)(a.ws + WS_O);
    const int gw = F.vcu * NWAVES + F.wave, NGW = F.G * NWAVES;
    const int q = F.lane >> 2, ds = F.lane & 3;
    constexpr int N_LAT = BATCH * 64 * 4 * NH, N_CTX = BATCH * (CTXL / 16) * NH;
    const int ntot = N_LAT + (ctx_queries ? N_CTX : 0);
    for (int u = gw; u < ntot; u += NGW) {
        const bool lat = u < N_LAT; int b, h, qrow, r = 0, j = 0, r0 = 0;
        if (lat) { h = u & 15; int t = u >> 4; j = t & 3; t >>= 2; r = t & 63; b = t >> 6; qrow = b * SEQ + r * GRIDW + j * 16 + q; r0 = r - 4; r0 = r0 < 0 ? 0 : (r0 > 56 ? 56 : r0); }
        else { int t = u - N_LAT; h = t & 15; t >>= 4; const int qb = t & 15; b = t >> 4; qrow = ML + b * CTXL + qb * 16 + q; }
        float qf[32], acc[32];
        { const bf16* qp = QKV + (size_t)qrow * (3 * D) + h * HD + ds * 32;
#pragma unroll
          for (int i = 0; i < 4; ++i) { const v4u w = *(const v4u*)(qp + 8 * i);
              qf[8 * i + 0] = bf_lo(w.x) * ATT_SCALE; qf[8 * i + 1] = bf_hi(w.x) * ATT_SCALE; qf[8 * i + 2] = bf_lo(w.y) * ATT_SCALE; qf[8 * i + 3] = bf_hi(w.y) * ATT_SCALE;
              qf[8 * i + 4] = bf_lo(w.z) * ATT_SCALE; qf[8 * i + 5] = bf_hi(w.z) * ATT_SCALE; qf[8 * i + 6] = bf_lo(w.w) * ATT_SCALE; qf[8 * i + 7] = bf_hi(w.w) * ATT_SCALE; } }
#pragma unroll
        for (int i = 0; i < 32; ++i) acc[i] = 0.f;
        float m = -1e30f, l = 0.f;
        const bf16* kc_base = QKV + (size_t)(ML + b * CTXL) * (3 * D) + D + h * HD + ds * 32;
        for (int k0 = 0; k0 < CTXL; k0 += 4) { ATT_CHUNK(kc_base + (size_t)(k0 + e) * (3 * D), true, 0.f); }
        if (lat) {
            const int qcol = j * 16 + q; int wst = qcol - 8; wst = wst < 0 ? 0 : (wst > 48 ? 48 : wst);
            int bs = j * 16 - 8; bs = bs < 0 ? 0 : (bs > 32 ? 32 : bs);
            const float* rp = rpb + (size_t)h * 15 * 31;
            for (int i = 0; i < 8; ++i) {
                const bf16* krow = QKV + (size_t)(b * SEQ + (r0 + i) * GRIDW + bs) * (3 * D) + D + h * HD + ds * 32;
                const float* rpi = rp + (r0 + i - r + 7) * 31;
                for (int c4 = 0; c4 < 32; c4 += 4) {
#define ATT_KC (bs + c4 + e)
#define ATT_DC (ATT_KC - qcol + 15)
                    ATT_CHUNK(krow + (size_t)(c4 + e) * (3 * D), (ATT_KC >= wst && ATT_KC < wst + 16), rpi[ATT_DC < 0 ? 0 : (ATT_DC > 30 ? 30 : ATT_DC)]);
#undef ATT_KC
#undef ATT_DC
                }
            }
        }
        const float inv = 1.0f / l;
        bf16* op = O + (size_t)qrow * D + h * HD + ds * 32;
#pragma unroll
        for (int i = 0; i < 4; ++i) { v4u w; w.x = pk2(acc[8 * i + 0] * inv, acc[8 * i + 1] * inv); w.y = pk2(acc[8 * i + 2] * inv, acc[8 * i + 3] * inv);
            w.z = pk2(acc[8 * i + 4] * inv, acc[8 * i + 5] * inv); w.w = pk2(acc[8 * i + 6] * inv, acc[8 * i + 7] * inv); *(v4u*)(op + 8 * i) = w; }
    }
}

constexpr int NPHASE = 3 + 7 * DEPTH;
__global__ void __launch_bounds__(NWAVES * 64, 2) fwd(Args args) {
    extern __shared__ __attribute__((aligned(16))) unsigned char lds[];
    Frame F;
    F.lds = (LAS unsigned char*)lds;
    F.MISC = (volatile LAS unsigned*)(F.lds + MISC_OFF);
    F.tid = threadIdx.x; F.lane = F.tid & 63; F.wave = __builtin_amdgcn_readfirstlane(F.tid >> 6);
    F.G = gridDim.x; { const int bx = blockIdx.x; F.vcu = (F.G % 8 == 0) ? (bx % 8) * (F.G / 8) + bx / 8 : bx; }
    unsigned char* ws = args.ws;
    F.ctl = (gu32*)(ws + WS_CTL);
    for (int u = F.tid; u < (LDS_BYTES - LDSCTL_OFF) / 4; u += NWAVES * 64) ((LAS unsigned*)(F.lds + LDSCTL_OFF))[u] = 0u;
    __syncthreads();
    const int lo = args.ph_lo, hi = args.ph_hi;
    const bool multi = (hi - lo) > 1;
    XcdBarrier bar; bar.bar = (unsigned*)(F.ctl + CW_BAR); bar.x = 0; bar.st = nullptr;
    if (multi) bar = xcd_barrier_post((unsigned*)(F.ctl + CW_BAR), F.MISC + 8);
#define IN(k) (lo <= (k) && (k) < hi)
#define SEAM(k) do { if (IN((k) + 1)) xcd_barrier(bar); } while (0)

    float* const X = (float*)(ws + WS_X);
    const float* const ADA = (const float*)(ws + WS_ADA);
    bf16* const H = (bf16*)(ws + WS_H);

    if (IN(0)) { p_ada_partial(F, args); __syncthreads(); p_convert_weights(F, args); p_copy_x(F, args); SEAM(0); }
    if (IN(1)) { p_ada_reduce(F, args); SEAM(1); }
    if (IN(2)) { p_modulate(F, args, MR, ADA, 0, D); SEAM(2); }

    for (int l = 0; l < DEPTH; ++l) {
        const int pb = 3 + 7 * l;
        const bool use_na = (l & 1) == 0; const int j = l >> 1;
        const int rows = l < 2 ? MR : ML;
        const float* ada_l = ADA + (size_t)l * NCOND * ADAW;
        if (use_na) {
            if (IN(pb + 0)) {
                pg8::Gemm g{H, (const bf16*)(ws + WS_WQKV) + (size_t)j * 3 * D * D, MR, 3 * D, D, D, D, 0, 0}; pg8::StaticOrder S; S.init(MR, 3 * D, F.G, (int)blockIdx.x);
                pg8::EpiBf16 E{(bf16*)(ws + WS_QKV), 3 * D};
                pg8::gemm_phase<pg8::EpiBf16, pg8::StaticOrder, true, true>(F.lds + RING_OFF, g, S, E);
                SEAM(pb + 0);
            }
            if (IN(pb + 1)) { p_attention_valu(F, args, args.na_rpb + (size_t)j * NH * 15 * 31, l == 0); SEAM(pb + 1); }
        } else {
            if (IN(pb + 0)) { p_pool(F, args, rows, ada_l); SEAM(pb + 0); }
        }
        if (IN(pb + 2)) {
            pg8::Gemm g; pg8::EpiRes E{X, D, ada_l + 2 * D, ADAW, nullptr, DN_ALPHA};
            if (use_na) g = pg8::Gemm{(const bf16*)(ws + WS_O), (const bf16*)(ws + WS_WO) + (size_t)j * D * D, rows, D, D, D, D, 0, 0};
            else { g = pg8::Gemm{(const bf16*)(ws + WS_O), (const bf16*)(ws + WS_WPOOL) + (size_t)j * D * 512, rows, D, 512, D, 512, 2, 512}; E.colscale = args.pool_scale + (size_t)j * D; }
            pg8::StaticOrder S; S.init(rows, D, F.G, (int)blockIdx.x);
            pg8::gemm_phase<pg8::EpiRes, pg8::StaticOrder, true, true>(F.lds + RING_OFF, g, S, E);
            SEAM(pb + 2);
        }
        if (IN(pb + 3)) { p_layernorm(F, args, rows, args.ln_mix_g + (size_t)l * D, args.ln_mix_b + (size_t)l * D, X, ada_l, 3 * D, 4 * D); SEAM(pb + 3); }
        if (IN(pb + 4)) {
            pg8::Gemm g{H, (const bf16*)(ws + WS_WIN) + (size_t)l * 2 * DFF * D, rows, 2 * DFF, D, D, D, 0, 0}; pg8::StaticOrder S; S.init(rows, 2 * DFF, F.G, (int)blockIdx.x);
            pg8::EpiSwiGLU E{(bf16*)(ws + WS_ACT), DFF};
            pg8::gemm_phase<pg8::EpiSwiGLU, pg8::StaticOrder, true, true>(F.lds + RING_OFF, g, S, E);
            SEAM(pb + 4);
        }
        if (IN(pb + 5)) {
            pg8::Gemm g{(const bf16*)(ws + WS_ACT), (const bf16*)(ws + WS_WOUT) + (size_t)l * D * DFF, rows, D, DFF, DFF, DFF, 0, 0}; pg8::StaticOrder S; S.init(rows, D, F.G, (int)blockIdx.x);
            pg8::EpiRes E{X, D, ada_l + 5 * D, ADAW, nullptr, DN_ALPHA};
            pg8::gemm_phase<pg8::EpiRes, pg8::StaticOrder, true, true>(F.lds + RING_OFF, g, S, E);
            SEAM(pb + 5);
        }
        if (IN(pb + 6)) {
            const bool last = (l == DEPTH - 1);
            const int nrows = l < 2 ? MR : ML;
            p_layernorm(F, args, nrows, args.ln_ffn_g + (size_t)l * D, args.ln_ffn_b + (size_t)l * D, last ? args.out : X, last ? nullptr : ada_l + (size_t)NCOND * ADAW, 0, D);
            if (!last) SEAM(pb + 6);
        }
    }
#undef IN
#undef SEAM
}

extern "C" void kernel_launch(void* const* d_in, const int* in_sizes, int n_in, void* d_out, int out_size, void* d_ws, size_t ws_size, hipStream_t stream) {
    static int grid = 0;
    if (grid == 0) {
        if (n_in != 17 || out_size != ML * D || ws_size < WS_END) { fprintf(stderr, "kernel_launch: unexpected shapes (n_in %d, out %d, ws %zu); nothing launched\n", n_in, out_size, ws_size); grid = -1; return; }
        int dev = 0, cus = 0, per_cu = 0;
        if (hipGetDevice(&dev) != hipSuccess || hipDeviceGetAttribute(&cus, hipDeviceAttributeMultiprocessorCount, dev) != hipSuccess) { grid = -1; return; }
        if (hipFuncSetAttribute((const void*)fwd, hipFuncAttributeMaxDynamicSharedMemorySize, LDS_BYTES) != hipSuccess) { fprintf(stderr, "kernel_launch: hipFuncSetAttribute failed\n"); grid = -1; return; }
        if (hipOccupancyMaxActiveBlocksPerMultiprocessor(&per_cu, (const void*)fwd, NWAVES * 64, LDS_BYTES) != hipSuccess || per_cu < 1)
            fprintf(stderr, "kernel_launch: note: occupancy query reports %d workgroups per CU\n", per_cu);
        (void)hipGetLastError();
        grid = cus;
    }
    if (grid < 0) return;
    if (hipMemsetAsync((char*)d_ws + WS_CTL, 0, CTL_ZERO_BYTES, stream) != hipSuccess) { fprintf(stderr, "kernel_launch: memset failed\n"); return; }
    Args a{};
    a.x = (const float*)d_in[0]; a.c = (const float*)d_in[1]; a.ctx = (const float*)d_in[2]; a.c_ctx = (const float*)d_in[3]; a.ada_w = (const float*)d_in[4]; a.ada_b = (const float*)d_in[5];
    a.ln_mix_g = (const float*)d_in[6]; a.ln_mix_b = (const float*)d_in[7]; a.ln_ffn_g = (const float*)d_in[8]; a.ln_ffn_b = (const float*)d_in[9];
    a.na_w_qkv = (const float*)d_in[10]; a.na_w_o = (const float*)d_in[11]; a.na_rpb = (const float*)d_in[12]; a.pool_w = (const float*)d_in[13]; a.pool_scale = (const float*)d_in[14];
    a.ffn_w_in = (const float*)d_in[15]; a.ffn_w_out = (const float*)d_in[16];
    a.out = (float*)d_out; a.ws = (unsigned char*)d_ws;
#if MK_ONE_LAUNCH
    a.ph_lo = 0; a.ph_hi = NPHASE;
    hipLaunchKernelGGL(fwd, dim3(grid), dim3(NWAVES * 64), LDS_BYTES, stream, a);
#else
    for (int p = 0; p < NPHASE; ++p) {
        const int l = (p - 3) / 7, s = (p - 3) % 7;
        if (p >= 3 && (l & 1) == 1 && s == 1) continue;
        a.ph_lo = p; a.ph_hi = p + 1;
        hipLaunchKernelGGL(fwd, dim3(grid), dim3(NWAVES * 64), LDS_BYTES, stream, a);
    }
#endif
    const hipError_t le = hipPeekAtLastError();
    if (le != hipSuccess) fprintf(stderr, "kernel_launch: launch failed: %s\n", hipGetErrorName(le));
}
```

```cpp
#include <hip/hip_runtime.h>
#include <cstdio>
#include <cstdint>

#ifndef MK_ONE_LAUNCH
#define MK_ONE_LAUNCH 1
#endif

namespace pg8 {
#define PG8_LAS __attribute__((address_space(3)))
typedef unsigned short bf16_t;
typedef short bf16x8 __attribute__((ext_vector_type(8)));
typedef float f32x4 __attribute__((ext_vector_type(4)));
typedef unsigned u32x4 __attribute__((ext_vector_type(4)));
constexpr int BM = 256, BK = 64, HALF = 128, HTB = HALF * BK * 2  , STAGE_BYTES = 8 * HTB, NXCD = 8, WGM = 8;

__host__ __device__ __forceinline__ int lds_byte(int r, int c) { const int st = (r >> 4) * 2 + (c >> 5), rr = r & 15, cc = c & 31, ob = rr * 64 + cc * 2; return st * 1024 + (ob ^ (((ob >> 9) & 1) << 5)); }
__host__ __device__ __forceinline__ void stage_rc(int b, int& R, int& C) { const int st = b / 1024, sb = b % 1024, swz = sb ^ (((sb >> 9) & 1) << 5); R = (st >> 1) * 16 + swz / 64; C = (st & 1) * 32 + (swz % 64) / 2; }
__host__ __device__ __forceinline__ int perm32(int rho) { const int n = rho >> 4, i = rho & 15; return 8 * (i >> 2) + 4 * n + (i & 3); }

__device__ __forceinline__ int opaque_v(int v) { asm volatile("" : "+v"(v)); return v; }
struct Unit { int pm, pn; };
struct Gemm { const bf16_t* A; const bf16_t* Bt; int M, N, K, lda, ldb, grp_pn, grp_k; };

struct StaticOrder {
    int nM, nN, nwg, G, c;
    __host__ __device__ void init(int M, int N, int G_, int c_) { nM = M / BM; nN = N / BM; nwg = nM * nN; G = G_; c = c_; }
    __host__ __device__ bool next(int i, Unit& u) const {
        const long L = (long)i * G + c; if (L >= nwg) return false;
        int wgid = (int)L; { const int q = nwg / NXCD, r = nwg % NXCD, xcd = wgid % NXCD, off = wgid / NXCD; wgid = (xcd < r ? xcd * (q + 1) : r * (q + 1) + (xcd - r) * q) + off; }
        const int nig = WGM * nN, gid = wgid / nig, fm = gid * WGM, gsz = (nM - fm) < WGM ? (nM - fm) : WGM;
        u.pm = fm + ((wgid % nig) % gsz); u.pn = (wgid % nig) / gsz; return true;
    }
    __device__ __forceinline__ void a_ready(const Unit&) const {}
    __device__ __forceinline__ void done(const Unit&) const {}
};

__device__ __forceinline__ unsigned cvt_pk_bf16(float lo, float hi) { unsigned r; asm volatile("v_cvt_pk_bf16_f32 %0, %1, %2" : "=v"(r) : "v"(lo), "v"(hi)); return r; }

struct EpiBf16 {
    static constexpr bool PERM = true, AFTER_DRAIN = false;
    bf16_t* O; int ldc;
    __device__ __forceinline__ void operator()(const f32x4 (&acc)[2][2][4][2], const Unit& u, int wr, int wc, int fr, int fq) const {
        const int row0 = u.pm * BM + wr * 64 + fr; const int col0 = u.pn * BM + wc * 32 + 8 * fq;
#pragma unroll
        for (int ai = 0; ai < 2; ++ai)
#pragma unroll
            for (int m = 0; m < 4; ++m) { bf16_t* rowp = O + (size_t)(row0 + ai * HALF + m * 16) * ldc + col0;
#pragma unroll
                for (int bj = 0; bj < 2; ++bj) { const f32x4 v0 = acc[ai][bj][m][0], v1 = acc[ai][bj][m][1];
                    u32x4 w; w.x = cvt_pk_bf16(v0[0], v0[1]); w.y = cvt_pk_bf16(v0[2], v0[3]); w.z = cvt_pk_bf16(v1[0], v1[1]); w.w = cvt_pk_bf16(v1[2], v1[3]);
                    *(u32x4*)(rowp + bj * HALF) = w; } }
    }
};
struct EpiSwiGLU {
    static constexpr bool PERM = true, AFTER_DRAIN = false;
    bf16_t* O; int ldc;
    __device__ __forceinline__ float act(float g, float u) const { return g * u * __builtin_amdgcn_rcpf(1.0f + __builtin_amdgcn_exp2f(g * -1.44269504089f)); }
    __device__ __forceinline__ void operator()(const f32x4 (&acc)[2][2][4][2], const Unit& u, int wr, int wc, int fr, int fq) const {
        const int row0 = u.pm * BM + wr * 64 + fr; const int col0 = u.pn * HALF + wc * 32 + 8 * fq;
#pragma unroll
        for (int ai = 0; ai < 2; ++ai)
#pragma unroll
            for (int m = 0; m < 4; ++m) { bf16_t* rowp = O + (size_t)(row0 + ai * HALF + m * 16) * ldc + col0;
                const f32x4 g0 = acc[ai][0][m][0], g1 = acc[ai][0][m][1], u0 = acc[ai][1][m][0], u1 = acc[ai][1][m][1];
                u32x4 w; w.x = cvt_pk_bf16(act(g0[0], u0[0]), act(g0[1], u0[1])); w.y = cvt_pk_bf16(act(g0[2], u0[2]), act(g0[3], u0[3]));
                w.z = cvt_pk_bf16(act(g1[0], u1[0]), act(g1[1], u1[1])); w.w = cvt_pk_bf16(act(g1[2], u1[2]), act(g1[3], u1[3]));
                *(u32x4*)rowp = w; }
    }
};
struct EpiRes {
    static constexpr bool PERM = false, AFTER_DRAIN = false;
    float* X; int ldx; const float* gate; int gate_stride; const float* colscale; float alpha;
    __device__ __forceinline__ void operator()(const f32x4 (&acc)[2][2][4][2], const Unit& u, int wr, int wc, int fr, int fq) const {
        const int row0 = u.pm * BM + wr * 64 + fr, col0 = u.pn * BM + wc * 32 + 4 * fq;
        const int cond = u.pm < 64 ? (u.pm >> 4) : 4;
        const float* gp = gate + (size_t)cond * gate_stride + col0;
        f32x4 gv[2][2];
#pragma unroll
        for (int bj = 0; bj < 2; ++bj)
#pragma unroll
            for (int n = 0; n < 2; ++n) { gv[bj][n] = *(const f32x4*)(gp + bj * HALF + n * 16); if (colscale) gv[bj][n] = gv[bj][n] * *(const f32x4*)(colscale + col0 + bj * HALF + n * 16); }
#pragma unroll
        for (int ai = 0; ai < 2; ++ai)
#pragma unroll
            for (int m = 0; m < 4; ++m) { float* rowp = X + (size_t)(row0 + ai * HALF + m * 16) * ldx + col0;
#pragma unroll
                for (int bj = 0; bj < 2; ++bj)
#pragma unroll
                    for (int n = 0; n < 2; ++n) { const f32x4 xv = *(const f32x4*)(rowp + bj * HALF + n * 16); *(f32x4*)(rowp + bj * HALF + n * 16) = xv * alpha + gv[bj][n] * acc[ai][bj][m][n]; }
                asm volatile("" ::: "memory"); }
    }
};

template <class Epi, class Sched, bool ALIGN_EPI = false, bool SP2 = false>
__device__ __forceinline__ void gemm_phase(PG8_LAS unsigned char* lds, const Gemm g, const Sched& S, const Epi& E) {
    const int tid = opaque_v(threadIdx.x), wid = __builtin_amdgcn_readfirstlane(tid >> 6), lane = tid & 63, wr = wid >> 2, wc = wid & 3, fr = lane & 15, fq = lane >> 4;
    const int K = g.K, nt = K / BK;
    unsigned voffA[2], voffB[2];
#pragma unroll
    for (int i = 0; i < 2; ++i) { int R, C; stage_rc(tid * 16 + i * 8192, R, C); const int Rb = Epi::PERM ? ((R & ~31) + perm32(R & 31)) : R;
        voffA[i] = (unsigned)(R * g.lda + C) * 2u; voffB[i] = (unsigned)(Rb * g.ldb + C) * 2u; }
    const size_t kstep = (size_t)(BK * 2);
    const size_t hstepA = (size_t)HALF * g.lda * 2, hstepB = (size_t)HALF * g.ldb * 2;
    const size_t tstepA = 2 * hstepA, tstepB = 2 * hstepB;
    const unsigned ldsw = (unsigned)wid * 1024u;
    const int aoff = lds_byte(wr * 64 + fr, fq * 8), boff = lds_byte(wc * 32 + fr, fq * 8);
#define PG8_SA(b, h) (((b) * 2 + (h)) * HTB)
#define PG8_SB(b, h) ((4 + (b) * 2 + (h)) * HTB)
#define PG8_STAGE(bufoff, gbase, voff) do { _Pragma("unroll") for (int _i = 0; _i < 2; ++_i) \
        __builtin_amdgcn_global_load_lds((const unsigned*)((const char*)(gbase) + (voff)[_i]), (PG8_LAS unsigned*)(lds + (bufoff) + ldsw + _i * 8192), 16, 0, 0); } while (0)
#define PG8_LDA(dst, b, h) do { _Pragma("unroll") for (int m = 0; m < 4; ++m) _Pragma("unroll") for (int k = 0; k < 2; ++k) dst[m][k] = *(const PG8_LAS bf16x8*)(lds + PG8_SA(b, h) + aoff + m * 2048 + k * 1024); } while (0)
#define PG8_LDB(dst, b, h) do { _Pragma("unroll") for (int n = 0; n < 2; ++n) _Pragma("unroll") for (int k = 0; k < 2; ++k) dst[n][k] = *(const PG8_LAS bf16x8*)(lds + PG8_SB(b, h) + boff + n * 2048 + k * 1024); } while (0)
#define PG8_MMA(ai, bj, At, Bt) do { __builtin_amdgcn_s_setprio(1); _Pragma("unroll") for (int m = 0; m < 4; ++m) _Pragma("unroll") for (int n = 0; n < 2; ++n) _Pragma("unroll") for (int k = 0; k < 2; ++k) \
        acc[ai][bj][m][n] = __builtin_amdgcn_mfma_f32_16x16x32_bf16(Bt[n][k], At[m][k], acc[ai][bj][m][n], 0, 0, 0); __builtin_amdgcn_s_setprio(0); } while (0)
#define PG8_WAIT_V(n) asm volatile("s_waitcnt vmcnt(" #n ")" ::: "memory")
#define PG8_WAIT_L(n) asm volatile("s_waitcnt lgkmcnt(" #n ")" ::: "memory")
#define PG8_BAR __builtin_amdgcn_s_barrier()
#define PG8_SCHED __builtin_amdgcn_sched_barrier(0)
#define PG8_AOF(u) ((size_t)(u).pm * tstepA + (g.grp_pn ? (size_t)((u).pn / g.grp_pn) * (size_t)g.grp_k * 2 : (size_t)0))
    Unit cur, nxt; int ui = 0;
    if (!S.next(0, cur)) return;
    f32x4 acc[2][2][4][2];
#pragma unroll
    for (int a = 0; a < 2; ++a)
#pragma unroll
        for (int b = 0; b < 2; ++b)
#pragma unroll
            for (int m = 0; m < 4; ++m)
#pragma unroll
                for (int n = 0; n < 2; ++n) acc[a][b][m][n] = (f32x4){0.f, 0.f, 0.f, 0.f};
    bf16x8 At[4][2], B0[2][2], B1[2][2];
    const char* cA = (const char*)g.A + PG8_AOF(cur); const char* cB = (const char*)g.Bt + (size_t)cur.pn * tstepB;
    S.a_ready(cur);
    if constexpr (SP2) {
        PG8_STAGE(PG8_SB(0, 0), cB, voffB); PG8_STAGE(PG8_SB(0, 1), cB + hstepB, voffB); PG8_STAGE(PG8_SA(0, 0), cA, voffA); PG8_STAGE(PG8_SA(0, 1), cA + hstepA, voffA);
        if (wr == 1) PG8_BAR;
        PG8_WAIT_V(2); PG8_BAR;
        PG8_STAGE(PG8_SB(1, 0), cB + kstep, voffB); PG8_STAGE(PG8_SA(1, 0), cA + kstep, voffA); PG8_STAGE(PG8_SB(1, 1), cB + hstepB + kstep, voffB);
        PG8_WAIT_V(6); PG8_BAR;
    } else {
        PG8_STAGE(PG8_SB(0, 0), cB, voffB); PG8_STAGE(PG8_SA(0, 0), cA, voffA); PG8_STAGE(PG8_SB(0, 1), cB + hstepB, voffB); PG8_STAGE(PG8_SA(0, 1), cA + hstepA, voffA);
        if (wr == 1) PG8_BAR;
        PG8_WAIT_V(4); PG8_BAR;
        PG8_STAGE(PG8_SB(1, 0), cB + kstep, voffB); PG8_STAGE(PG8_SA(1, 0), cA + kstep, voffA); PG8_STAGE(PG8_SB(1, 1), cB + hstepB + kstep, voffB);
        PG8_WAIT_V(6); PG8_BAR;
    }
    for (;;) {
        const bool has_next = S.next(ui + 1, nxt);
        const char* nA = has_next ? (const char*)g.A + PG8_AOF(nxt) : cA; const char* nB = has_next ? (const char*)g.Bt + (size_t)nxt.pn * tstepB : cB;
        for (int t = 0; t < nt; t += 2) {
            const bool last = (t == nt - 2);
            const char* a1 = cA + (size_t)(t + 1) * kstep;
            const char* a2 = last ? nA : cA + (size_t)(t + 2) * kstep; const char* b2 = last ? nB : cB + (size_t)(t + 2) * kstep;
            const char* a3 = a2 + kstep; const char* b3 = b2 + kstep;
            if (last && has_next) S.a_ready(nxt);
            if constexpr (SP2) {
            PG8_LDB(B0, 0, 0); PG8_LDB(B1, 0, 1); PG8_SCHED; PG8_LDA(At, 0, 0); PG8_STAGE(PG8_SA(1, 1), a1 + hstepA, voffA);
            PG8_WAIT_V(8); PG8_WAIT_L(0); PG8_BAR; PG8_MMA(0, 0, At, B0); PG8_MMA(0, 1, At, B1); PG8_BAR; PG8_SCHED;
            PG8_LDA(At, 0, 1); PG8_STAGE(PG8_SB(0, 0), b2, voffB); PG8_STAGE(PG8_SB(0, 1), b2 + hstepB, voffB); PG8_STAGE(PG8_SA(0, 0), a2, voffA);
            PG8_WAIT_V(8); PG8_WAIT_L(0); PG8_BAR; PG8_MMA(1, 0, At, B0); PG8_MMA(1, 1, At, B1); PG8_BAR; PG8_SCHED;
            PG8_LDB(B0, 1, 0); PG8_LDB(B1, 1, 1); PG8_SCHED; PG8_LDA(At, 1, 0); PG8_STAGE(PG8_SA(0, 1), a2 + hstepA, voffA);
            PG8_WAIT_V(8); PG8_WAIT_L(0); PG8_BAR; PG8_MMA(0, 0, At, B0); PG8_MMA(0, 1, At, B1); PG8_BAR; PG8_SCHED;
            PG8_LDA(At, 1, 1); PG8_STAGE(PG8_SB(1, 0), b3, voffB); PG8_STAGE(PG8_SB(1, 1), b3 + hstepB, voffB); PG8_STAGE(PG8_SA(1, 0), a3, voffA);
            PG8_WAIT_V(8); PG8_WAIT_L(0); PG8_BAR; PG8_MMA(1, 0, At, B0); PG8_MMA(1, 1, At, B1); PG8_BAR; PG8_SCHED;
            } else {
            PG8_LDB(B0, 0, 0); PG8_SCHED; PG8_LDA(At, 0, 0); PG8_STAGE(PG8_SA(1, 1), a1 + hstepA, voffA);
            PG8_WAIT_L(8); PG8_BAR; PG8_WAIT_L(0); PG8_MMA(0, 0, At, B0); PG8_BAR; PG8_SCHED;
            PG8_LDB(B1, 0, 1); PG8_STAGE(PG8_SB(0, 0), b2, voffB);
            PG8_BAR; PG8_WAIT_L(0); PG8_MMA(0, 1, At, B1); PG8_BAR;
            PG8_LDA(At, 0, 1); PG8_STAGE(PG8_SA(0, 0), a2, voffA);
            PG8_BAR; PG8_WAIT_L(0); PG8_MMA(1, 0, At, B0); PG8_BAR; PG8_SCHED;
            PG8_STAGE(PG8_SB(0, 1), b2 + hstepB, voffB);
            PG8_WAIT_V(6); PG8_BAR; PG8_MMA(1, 1, At, B1); PG8_BAR;
            PG8_LDB(B0, 1, 0); PG8_SCHED; PG8_LDA(At, 1, 0); PG8_STAGE(PG8_SA(0, 1), a2 + hstepA, voffA);
            PG8_WAIT_L(8); PG8_BAR; PG8_WAIT_L(0); PG8_MMA(0, 0, At, B0); PG8_BAR; PG8_SCHED;
            PG8_LDB(B1, 1, 1); PG8_STAGE(PG8_SB(1, 0), b3, voffB);
            PG8_BAR; PG8_WAIT_L(0); PG8_MMA(0, 1, At, B1); PG8_BAR;
            PG8_LDA(At, 1, 1); PG8_STAGE(PG8_SA(1, 0), a3, voffA);
            PG8_BAR; PG8_WAIT_L(0); PG8_MMA(1, 0, At, B0); PG8_BAR; PG8_SCHED;
            PG8_STAGE(PG8_SB(1, 1), b3 + hstepB, voffB);
            PG8_WAIT_V(6); PG8_BAR; PG8_MMA(1, 1, At, B1); PG8_BAR;
            }
        }
        if constexpr (ALIGN_EPI) { if (wr == 0) PG8_BAR; }
        if constexpr (!Epi::AFTER_DRAIN) { E(acc, cur, wr, wc, fr, fq); S.done(cur); }
        if (!has_next) break;
#pragma unroll
        for (int a = 0; a < 2; ++a)
#pragma unroll
            for (int b = 0; b < 2; ++b)
#pragma unroll
                for (int m = 0; m < 4; ++m)
#pragma unroll
                    for (int n = 0; n < 2; ++n) acc[a][b][m][n] = (f32x4){0.f, 0.f, 0.f, 0.f};
        cur = nxt; cA = nA; cB = nB; ++ui;
        if constexpr (ALIGN_EPI) { if (wr == 1) PG8_BAR; }
    }
    PG8_WAIT_V(0);
    if constexpr (!ALIGN_EPI) { if (wr == 0) PG8_BAR; }
    PG8_BAR;
#undef PG8_AOF
#undef PG8_SA
#undef PG8_SB
#undef PG8_STAGE
#undef PG8_LDA
#undef PG8_LDB
#undef PG8_MMA
#undef PG8_WAIT_V
#undef PG8_WAIT_L
#undef PG8_BAR
#undef PG8_SCHED
}
}

constexpr int NWAVES = 8;
constexpr int D = 2048, BATCH = 4, SEQ = 4096, DEPTH = 4, CTXL = 256, GRIDW = 64, NH = 16, HD = 128;
constexpr int DFF = 5632, NADA = 6;
constexpr int ML = BATCH * SEQ;
constexpr int MC = BATCH * CTXL;
constexpr int MR = ML + MC;
constexpr int NCOND = BATCH + 1;
constexpr int ADAW = NADA * D;
constexpr float LN_EPS = 1e-5f;
constexpr float DN_ALPHA = 1.6817928305074290f;
constexpr float ATT_SCALE = 0.08838834764831845f;
constexpr int KSPLIT = 32;

constexpr size_t MiB = 1u << 20;
constexpr size_t WS_CTL = 0, CTL_ZERO_BYTES = 1 * MiB;
constexpr size_t WS_ADA = 1 * MiB;
constexpr size_t WS_PART = 2 * MiB;
constexpr size_t WS_WQKV = 34 * MiB;
constexpr size_t WS_WO = 82 * MiB;
constexpr size_t WS_WPOOL = 98 * MiB;
constexpr size_t WS_WIN = 102 * MiB;
constexpr size_t WS_WOUT = 278 * MiB;
constexpr size_t WS_X = 366 * MiB;
constexpr size_t WS_H = 502 * MiB;
constexpr size_t WS_QKV = 570 * MiB;
constexpr size_t WS_O = 774 * MiB;
constexpr size_t WS_ACT = 842 * MiB;
constexpr size_t WS_END = 1030 * MiB;
constexpr int CW_TMO = 0, CW_CODE = 1;
constexpr int CW_BAR = 4096;

constexpr int RING_OFF = 0, RING_BYTES = 131072;
constexpr int LDSCTL_OFF = RING_BYTES, MISC_OFF = LDSCTL_OFF + 320;
constexpr int LDS_BYTES = 147456;

#define GAS __attribute__((address_space(1)))
#define LAS __attribute__((address_space(3)))
typedef unsigned short bf16;
typedef unsigned v4u __attribute__((ext_vector_type(4)));
typedef unsigned v2u __attribute__((ext_vector_type(2)));
typedef float f32x4 __attribute__((ext_vector_type(4)));
typedef GAS unsigned gu32;
#define RLX_AGENT __ATOMIC_RELAXED, __HIP_MEMORY_SCOPE_AGENT
#define LDS_WAIT() asm volatile("s_waitcnt lgkmcnt(0)" ::: "memory")
#define VM_WAIT() asm volatile("s_waitcnt vmcnt(0)" ::: "memory")
__device__ __forceinline__ unsigned f2bf(float f) { unsigned u = __builtin_bit_cast(unsigned, f); return (u + 0x7fffu + ((u >> 16) & 1u)) >> 16; }
__device__ __forceinline__ unsigned pk2(float lo, float hi) { return f2bf(lo) | (f2bf(hi) << 16); }
__device__ __forceinline__ float bf_lo(unsigned w) { return __builtin_bit_cast(float, w << 16); }
__device__ __forceinline__ float bf_hi(unsigned w) { return __builtin_bit_cast(float, w & 0xffff0000u); }

#define XB_TMO      128
#define XB_XCNT(j)  (256  + 64 * (j))
#define XB_XSUB(j)  (1280 + 64 * (j))
#define XB_XGEN(j)  (2304 + 64 * (j))
#define XB_TOP      3328
#define XB_TOPGEN   3392
#define XCD_BAR_WORDS 3456
#define XB_SPIN_CAP (1u << 18)

__device__ __forceinline__ unsigned xb_ld(unsigned* p)              { return __hip_atomic_load(p, __ATOMIC_RELAXED, __HIP_MEMORY_SCOPE_AGENT); }
__device__ __forceinline__ unsigned xb_add(unsigned* p, unsigned v) { return __hip_atomic_fetch_add(p, v, __ATOMIC_RELAXED, __HIP_MEMORY_SCOPE_AGENT); }
__device__ __forceinline__ unsigned xb_xcc_id() { return (unsigned)__builtin_amdgcn_s_getreg((3 << 11) | 20) & 0xFu; }
#define XB_SPIN(cond, bar) do { unsigned _sp = 0; while (cond) { __builtin_amdgcn_s_sleep(1); \
    if ((++_sp & 255u) == 0u) { if (xb_ld(&(bar)[XB_TMO])) break; if (_sp > XB_SPIN_CAP) { atomicAdd(&(bar)[XB_TMO], 1u); break; } } } } while (0)

struct XcdBarrier { unsigned* bar; unsigned x; volatile LAS unsigned* st; };

__device__ __forceinline__ XcdBarrier xcd_barrier_post(unsigned* bar, volatile LAS unsigned* st) {
    XcdBarrier b; b.bar = bar; b.x = xb_xcc_id(); b.st = st;
    if (threadIdx.x == 0) (void)xb_add(&bar[XB_XCNT(b.x)], 1u);
    return b;
}
__device__ __forceinline__ void xcd_barrier_complete(unsigned* bar, unsigned x, unsigned& nloc, unsigned& nx) {
    const unsigned G = gridDim.x * gridDim.y * gridDim.z;
    unsigned sum, cnt, mine, sp = 0u;
    for (;;) {
        sum = 0u; cnt = 0u; mine = 0u;
#pragma unroll
        for (unsigned j = 0; j < 16; ++j) { const unsigned c = xb_ld(&bar[XB_XCNT(j)]); sum += c; cnt += (c > 0u) ? 1u : 0u; mine = (j == x) ? c : mine; }
        if (sum == G) break;
        __builtin_amdgcn_s_sleep(1);
        if ((++sp & 255u) == 0u) { if (xb_ld(&bar[XB_TMO])) break; if (sp > XB_SPIN_CAP) { atomicAdd(&bar[XB_TMO], 1u); break; } }
    }
    nloc = mine > 0u ? mine : 1u; nx = cnt > 0u ? cnt : 1u;
}
__device__ __forceinline__ void xcd_barrier(const XcdBarrier& b) {
    asm volatile("s_waitcnt vmcnt(0)" ::: "memory");
    __syncthreads();
    if (threadIdx.x == 0) {
        unsigned* bar = b.bar;
        __builtin_amdgcn_s_waitcnt(0);
        unsigned nloc = b.st[0], nx = b.st[1];
        if (nloc == 0u) { xcd_barrier_complete(bar, b.x, nloc, nx); b.st[0] = nloc; b.st[1] = nx; }
        const unsigned old = xb_add(&bar[XB_XSUB(b.x)], 1u);
        const unsigned gen = old / nloc;
        if (old + 1u == (gen + 1u) * nloc) {
            __builtin_amdgcn_fence(__ATOMIC_RELEASE, "agent");
            asm volatile("s_waitcnt vmcnt(0)" ::: "memory");
            const unsigned og = xb_add(&bar[XB_TOP], 1u);
            const unsigned tg = og / nx;
            if (og + 1u == (tg + 1u) * nx) xb_add(&bar[XB_TOPGEN], 1u);
            else XB_SPIN(xb_ld(&bar[XB_TOPGEN]) == tg, bar);
            __builtin_amdgcn_fence(__ATOMIC_ACQUIRE, "agent");
            xb_add(&bar[XB_XGEN(b.x)], 1u);
            asm volatile("s_waitcnt vmcnt(0)" ::: "memory");
        } else {
            XB_SPIN(xb_ld(&bar[XB_XGEN(b.x)]) == gen, bar);
            __builtin_amdgcn_fence(__ATOMIC_ACQUIRE, "agent");
            asm volatile("s_waitcnt vmcnt(0)" ::: "memory");
        }
    }
    __syncthreads();
}

struct Args {
    const float *x, *c, *ctx, *c_ctx, *ada_w, *ada_b, *ln_mix_g, *ln_mix_b, *ln_ffn_g, *ln_ffn_b, *na_w_qkv, *na_w_o, *na_rpb, *pool_w, *pool_scale, *ffn_w_in, *ffn_w_out;
    float* out; unsigned char* ws; int ph_lo, ph_hi;
};
struct Frame {
    LAS unsigned char* lds;
    volatile LAS unsigned* MISC;
    gu32* ctl;
    int tid, lane, wave;
    int vcu, G;
};

__device__ __forceinline__ float wave_sum(float v) {
#pragma unroll
    for (int o = 1; o < 64; o <<= 1) v += __shfl_xor(v, o);
    return v;
}
__device__ __forceinline__ float silu_f(float v) { return v / (1.0f + __expf(-v)); }

__device__ __forceinline__ void transpose_item(const float* W, int N, bf16* WT, int ldt, int drow0, LAS float* scr, int k0, int n0, int lane) {
#pragma unroll 8
    for (int i = 0; i < 32; ++i) { const int kk = 2 * i + (lane >> 5); scr[kk * 33 + (lane & 31)] = W[(size_t)(k0 + kk) * N + n0 + (lane & 31)]; }
    LDS_WAIT(); asm volatile("" ::: "memory");
    const int c = lane & 7;
#pragma unroll
    for (int j = 0; j < 4; ++j) { const int n = (lane >> 3) + 8 * j; const LAS float* s = scr + (8 * c) * 33 + n;
        v4u o; o.x = pk2(s[0 * 33], s[1 * 33]); o.y = pk2(s[2 * 33], s[3 * 33]); o.z = pk2(s[4 * 33], s[5 * 33]); o.w = pk2(s[6 * 33], s[7 * 33]);
        *(GAS v4u*)(WT + (size_t)(drow0 + n) * ldt + k0 + 8 * c) = o; }
    LDS_WAIT(); asm volatile("" ::: "memory");
}

__device__ __forceinline__ void p_convert_weights(Frame F, const Args& a) {
    F.tid = pg8::opaque_v(F.tid); F.lane = F.tid & 63;
    LAS float* scr = (LAS float*)(F.lds + RING_OFF + F.wave * 16384);
    const int gw = F.vcu * NWAVES + F.wave, NGW = F.G * NWAVES;
    unsigned char* ws = a.ws;
    constexpr int I_QKV = (D / 64) * (3 * D / 32), I_O = (D / 64) * (D / 32), I_POOL = (512 / 64) * (512 / 32), I_IN = (D / 64) * (2 * DFF / 32), I_OUT = (DFF / 64) * (D / 32);
    constexpr int T_QKV = 2 * I_QKV, T_O = 2 * I_O, T_POOL = 8 * I_POOL, T_IN = 4 * I_IN, T_OUT = 4 * I_OUT;
    constexpr int NITEMS = T_QKV + T_O + T_POOL + T_IN + T_OUT;
    for (int it = gw; it < NITEMS; it += NGW) {
        int r = it;
        if (r < T_QKV) { const int j = r / I_QKV, q = r % I_QKV, nblk = 3 * D / 32, kb = q / nblk, nb = q % nblk;
            transpose_item(a.na_w_qkv + (size_t)j * D * 3 * D, 3 * D, (bf16*)(ws + WS_WQKV) + (size_t)j * 3 * D * D, D, 32 * nb, scr, 64 * kb, 32 * nb, F.lane); continue; } r -= T_QKV;
        if (r < T_O) { const int j = r / I_O, q = r % I_O, nblk = D / 32, kb = q / nblk, nb = q % nblk;
            transpose_item(a.na_w_o + (size_t)j * D * D, D, (bf16*)(ws + WS_WO) + (size_t)j * D * D, D, 32 * nb, scr, 64 * kb, 32 * nb, F.lane); continue; } r -= T_O;
        if (r < T_POOL) { const int jg = r / I_POOL, q = r % I_POOL, nblk = 512 / 32, kb = q / nblk, nb = q % nblk;
            transpose_item(a.pool_w + (size_t)jg * 512 * 512, 512, (bf16*)(ws + WS_WPOOL) + (size_t)(jg >> 2) * D * 512, 512, (jg & 3) * 512 + 32 * nb, scr, 64 * kb, 32 * nb, F.lane); continue; } r -= T_POOL;
        if (r < T_IN) { const int l = r / I_IN, q = r % I_IN, nblk = 2 * DFF / 32, kb = q / nblk, nb = q % nblk; const int n0 = 32 * nb, bj = n0 / DFF, jj = n0 % DFF;
            transpose_item(a.ffn_w_in + (size_t)l * D * 2 * DFF, 2 * DFF, (bf16*)(ws + WS_WIN) + (size_t)l * 2 * DFF * D, D, 256 * (jj / 128) + 128 * bj + (jj % 128), scr, 64 * kb, n0, F.lane); continue; } r -= T_IN;
        { const int l = r / I_OUT, q = r % I_OUT, nblk = D / 32, kb = q / nblk, nb = q % nblk;
            transpose_item(a.ffn_w_out + (size_t)l * DFF * D, D, (bf16*)(ws + WS_WOUT) + (size_t)l * D * DFF, DFF, 32 * nb, scr, 64 * kb, 32 * nb, F.lane); }
    }
}
__device__ __forceinline__ void p_copy_x(Frame F, const Args& a) {
    F.tid = pg8::opaque_v(F.tid); F.lane = F.tid & 63;
    float* X = (float*)(a.ws + WS_X);
    const size_t n4l = (size_t)ML * D / 4, n4c = (size_t)MC * D / 4, stride = (size_t)F.G * 512;
    const f32x4* s0 = (const f32x4*)a.x; const f32x4* s1 = (const f32x4*)a.ctx; f32x4* d = (f32x4*)X;
    for (size_t i = (size_t)F.vcu * 512 + F.tid; i < n4l + n4c; i += stride) d[i] = i < n4l ? s0[i] : s1[i - n4l];
}
__device__ __forceinline__ void p_ada_partial(Frame F, const Args& a) {
    F.tid = pg8::opaque_v(F.tid); F.lane = F.tid & 63;
    LAS float* sc = (LAS float*)(F.lds + RING_OFF);
    float* PART = (float*)(a.ws + WS_PART);
    constexpr int NCC = ADAW / 2048, NITEMS = DEPTH * NCC * KSPLIT;
    for (int it = F.vcu; it < NITEMS; it += F.G) {
        const int kc = it % KSPLIT, cc = (it / KSPLIT) % NCC, l = it / (KSPLIT * NCC);
        __syncthreads();
        if (F.tid < NCOND * 64) { const int i = F.tid >> 6, k = kc * 64 + (F.tid & 63); const float v = i < BATCH ? a.c[i * D + k] : a.c_ctx[k]; sc[F.tid] = silu_f(v); }
        __syncthreads();
        const float* wp = a.ada_w + ((size_t)l * D + kc * 64) * ADAW + cc * 2048 + 4 * F.tid;
        f32x4 acc[NCOND];
#pragma unroll
        for (int i = 0; i < NCOND; ++i) acc[i] = (f32x4){0.f, 0.f, 0.f, 0.f};
#pragma unroll 8
        for (int k = 0; k < 64; ++k) { const f32x4 w = *(const f32x4*)(wp + (size_t)k * ADAW);
#pragma unroll
            for (int i = 0; i < NCOND; ++i) acc[i] += w * sc[i * 64 + k]; }
#pragma unroll
        for (int i = 0; i < NCOND; ++i) *(f32x4*)(PART + (((size_t)kc * DEPTH + l) * NCOND + i) * ADAW + cc * 2048 + 4 * F.tid) = acc[i];
    }
}
__device__ __forceinline__ void p_ada_reduce(Frame F, const Args& a) {
    F.tid = pg8::opaque_v(F.tid); F.lane = F.tid & 63;
    const float* PART = (const float*)(a.ws + WS_PART); float* ADA = (float*)(a.ws + WS_ADA);
    constexpr int N4 = DEPTH * NCOND * ADAW / 4;
    for (int i = F.vcu * 512 + F.tid; i < N4; i += F.G * 512) {
        const int col4 = i % (ADAW / 4), l = i / (NCOND * ADAW / 4);
        f32x4 s = *(const f32x4*)(a.ada_b + (size_t)l * ADAW + 4 * col4);
        for (int kc = 0; kc < KSPLIT; ++kc) s += *(const f32x4*)(PART + (size_t)kc * DEPTH * NCOND * ADAW + 4 * (size_t)i);
        *(f32x4*)(ADA + 4 * (size_t)i) = s;
    }
}
__device__ __forceinline__ void p_modulate(Frame F, const Args& a, int nrows, const float* ada_l, int sh_off, int sc_off) {
    F.tid = pg8::opaque_v(F.tid); F.lane = F.tid & 63;
    const float* X = (const float*)(a.ws + WS_X); bf16* H = (bf16*)(a.ws + WS_H);
    const int gw = F.vcu * NWAVES + F.wave, NGW = F.G * NWAVES;
    for (int r = gw; r < nrows; r += NGW) {
        const int cond = r < ML ? r / SEQ : BATCH; const float* ap = ada_l + (size_t)cond * ADAW;
#pragma unroll
        for (int j = 0; j < 8; ++j) { const int col = 4 * F.lane + 256 * j; const f32x4 v = *(const f32x4*)(X + (size_t)r * D + col), sh = *(const f32x4*)(ap + sh_off + col), sc = *(const f32x4*)(ap + sc_off + col);
            const f32x4 h = v * (sc + 1.0f) + sh; v2u o; o.x = pk2(h[0], h[1]); o.y = pk2(h[2], h[3]); *(v2u*)(H + (size_t)r * D + col) = o; }
    }
}
__device__ __forceinline__ void p_layernorm(Frame F, const Args& a, int nrows, const float* g, const float* b, float* outp, const float* ada_n, int sh_off, int sc_off) {
    F.tid = pg8::opaque_v(F.tid); F.lane = F.tid & 63;
    float* X = (float*)(a.ws + WS_X); bf16* H = (bf16*)(a.ws + WS_H);
    const int gw = F.vcu * NWAVES + F.wave, NGW = F.G * NWAVES;
    for (int r = gw; r < nrows; r += NGW) {
        f32x4 v[8]; float s = 0.f;
#pragma unroll
        for (int j = 0; j < 8; ++j) { v[j] = *(const f32x4*)(X + (size_t)r * D + 4 * F.lane + 256 * j); s += (v[j][0] + v[j][1]) + (v[j][2] + v[j][3]); }
        const float mean = wave_sum(s) * (1.f / D); float s2 = 0.f;
#pragma unroll
        for (int j = 0; j < 8; ++j) { v[j] = v[j] - mean; s2 += (v[j][0] * v[j][0] + v[j][1] * v[j][1]) + (v[j][2] * v[j][2] + v[j][3] * v[j][3]); }
        const float rstd = 1.f / sqrtf(wave_sum(s2) * (1.f / D) + LN_EPS);
        const int cond = r < ML ? r / SEQ : BATCH;
#pragma unroll
        for (int j = 0; j < 8; ++j) { const int col = 4 * F.lane + 256 * j; const f32x4 y = v[j] * rstd * *(const f32x4*)(g + col) + *(const f32x4*)(b + col);
            *(f32x4*)(outp + (size_t)r * D + col) = y;
            if (ada_n) { const float* ap = ada_n + (size_t)cond * ADAW; const f32x4 h = y * (*(const f32x4*)(ap + sc_off + col) + 1.0f) + *(const f32x4*)(ap + sh_off + col);
                v2u o; o.x = pk2(h[0], h[1]); o.y = pk2(h[2], h[3]); *(v2u*)(H + (size_t)r * D + col) = o; } }
    }
}
__device__ __forceinline__ void p_pool(Frame F, const Args& a, int nrows, const float* ada_l) {
    F.tid = pg8::opaque_v(F.tid); F.lane = F.tid & 63;
    const float* X = (const float*)(a.ws + WS_X); bf16* P = (bf16*)(a.ws + WS_O);
    const int gw = F.vcu * NWAVES + F.wave, NGW = F.G * NWAVES;
    for (int r = gw; r < nrows; r += NGW) {
        int base, t, L, cond;
        if (r < ML) { cond = r / SEQ; base = cond * SEQ; t = r - base; L = SEQ; } else { const int q = r - ML; cond = BATCH; base = ML + (q / CTXL) * CTXL; t = q % CTXL; L = CTXL; }
        const float* ap = ada_l + (size_t)cond * ADAW + D;
#pragma unroll
        for (int j = 0; j < 8; ++j) { const int col = 4 * F.lane + 256 * j; const int w = 2 << (j >> 1);
            int lo = t - w / 2, hi = lo + w; lo = lo < 0 ? 0 : lo; hi = hi > L ? L : hi;
            f32x4 s = (f32x4){0.f, 0.f, 0.f, 0.f};
            for (int tt = lo; tt < hi; ++tt) s += *(const f32x4*)(X + (size_t)(base + tt) * D + col);
            const f32x4 xv = *(const f32x4*)(X + (size_t)r * D + col), sc = *(const f32x4*)(ap + col);
            const f32x4 p = (s * (1.0f / (float)(hi - lo)) - xv) * (sc + 1.0f);
            v2u o; o.x = pk2(p[0], p[1]); o.y = pk2(p[2], p[3]); *(v2u*)(P + (size_t)r * D + col) = o; }
    }
}

#define ATT_CHUNK(KEYPTR_EXPR, VALID_EXPR, BIAS_EXPR) do { \
    float s_[4]; v4u kk_[4][4]; \
    _Pragma("unroll") for (int e = 0; e < 4; ++e) { const bf16* kp_ = (KEYPTR_EXPR); _Pragma("unroll") for (int i = 0; i < 4; ++i) kk_[e][i] = *(const v4u*)(kp_ + 8 * i); } \
    _Pragma("unroll") for (int e = 0; e < 4; ++e) { float d_ = 0.f; \
        _Pragma("unroll") for (int i = 0; i < 4; ++i) { const v4u w_ = kk_[e][i]; \
            d_ += qf[8 * i + 0] * bf_lo(w_.x) + qf[8 * i + 1] * bf_hi(w_.x) + qf[8 * i + 2] * bf_lo(w_.y) + qf[8 * i + 3] * bf_hi(w_.y) \
                + qf[8 * i + 4] * bf_lo(w_.z) + qf[8 * i + 5] * bf_hi(w_.z) + qf[8 * i + 6] * bf_lo(w_.w) + qf[8 * i + 7] * bf_hi(w_.w); } \
        d_ += __shfl_xor(d_, 1); d_ += __shfl_xor(d_, 2); \
        s_[e] = (VALID_EXPR) ? d_ + (BIAS_EXPR) : -1e30f; } \
    const float cm_ = fmaxf(fmaxf(s_[0], s_[1]), fmaxf(s_[2], s_[3])); const float mn_ = fmaxf(m, cm_); const float rs_ = __expf(m - mn_); m = mn_; l *= rs_; \
    _Pragma("unroll") for (int i = 0; i < 32; ++i) acc[i] *= rs_; \
    _Pragma("unroll") for (int e = 0; e < 4; ++e) { const float p_ = (s_[e] > -1e29f) ? __expf(s_[e] - m) : 0.f; l += p_; const bf16* vp_ = (KEYPTR_EXPR) + D; \
        _Pragma("unroll") for (int i = 0; i < 4; ++i) { const v4u w_ = *(const v4u*)(vp_ + 8 * i); \
            acc[8 * i + 0] += p_ * bf_lo(w_.x); acc[8 * i + 1] += p_ * bf_hi(w_.x); acc[8 * i + 2] += p_ * bf_lo(w_.y); acc[8 * i + 3] += p_ * bf_hi(w_.y); \
            acc[8 * i + 4] += p_ * bf_lo(w_.z); acc[8 * i + 5] += p_ * bf_hi(w_.z); acc[8 * i + 6] += p_ * bf_lo(w_.w); acc[8 * i + 7] += p_ * bf_hi(w_.w); } } \
} while (0)

__device__ __forceinline__ void p_attention_valu(Frame F, const Args& a, const float* rpb, bool ctx_queries) {
    F.tid = pg8::opaque_v(F.tid); F.lane = F.tid & 63;
    const bf16* QKV = (const bf16*)(a.ws + WS_QKV); bf16* O = (bf16*)(a.ws + WS_O);
    const int gw = F.vcu * NWAVES + F.wave, NGW = F.G * NWAVES;
    const int q = F.lane >> 2, ds = F.lane & 3;
    constexpr int N_LAT = BATCH * 64 * 4 * NH, N_CTX = BATCH * (CTXL / 16) * NH;
    const int ntot = N_LAT + (ctx_queries ? N_CTX : 0);
    for (int u = gw; u < ntot; u += NGW) {
        const bool lat = u < N_LAT; int b, h, qrow, r = 0, j = 0, r0 = 0;
        if (lat) { h = u & 15; int t = u >> 4; j = t & 3; t >>= 2; r = t & 63; b = t >> 6; qrow = b * SEQ + r * GRIDW + j * 16 + q; r0 = r - 4; r0 = r0 < 0 ? 0 : (r0 > 56 ? 56 : r0); }
        else { int t = u - N_LAT; h = t & 15; t >>= 4; const int qb = t & 15; b = t >> 4; qrow = ML + b * CTXL + qb * 16 + q; }
        float qf[32], acc[32];
        { const bf16* qp = QKV + (size_t)qrow * (3 * D) + h * HD + ds * 32;
#pragma unroll
          for (int i = 0; i < 4; ++i) { const v4u w = *(const v4u*)(qp + 8 * i);
              qf[8 * i + 0] = bf_lo(w.x) * ATT_SCALE; qf[8 * i + 1] = bf_hi(w.x) * ATT_SCALE; qf[8 * i + 2] = bf_lo(w.y) * ATT_SCALE; qf[8 * i + 3] = bf_hi(w.y) * ATT_SCALE;
              qf[8 * i + 4] = bf_lo(w.z) * ATT_SCALE; qf[8 * i + 5] = bf_hi(w.z) * ATT_SCALE; qf[8 * i + 6] = bf_lo(w.w) * ATT_SCALE; qf[8 * i + 7] = bf_hi(w.w) * ATT_SCALE; } }
#pragma unroll
        for (int i = 0; i < 32; ++i) acc[i] = 0.f;
        float m = -1e30f, l = 0.f;
        const bf16* kc_base = QKV + (size_t)(ML + b * CTXL) * (3 * D) + D + h * HD + ds * 32;
        for (int k0 = 0; k0 < CTXL; k0 += 4) { ATT_CHUNK(kc_base + (size_t)(k0 + e) * (3 * D), true, 0.f); }
        if (lat) {
            const int qcol = j * 16 + q; int wst = qcol - 8; wst = wst < 0 ? 0 : (wst > 48 ? 48 : wst);
            int bs = j * 16 - 8; bs = bs < 0 ? 0 : (bs > 32 ? 32 : bs);
            const float* rp = rpb + (size_t)h * 15 * 31;
            for (int i = 0; i < 8; ++i) {
                const bf16* krow = QKV + (size_t)(b * SEQ + (r0 + i) * GRIDW + bs) * (3 * D) + D + h * HD + ds * 32;
                const float* rpi = rp + (r0 + i - r + 7) * 31;
                for (int c4 = 0; c4 < 32; c4 += 4) {
#define ATT_KC (bs + c4 + e)
#define ATT_DC (ATT_KC - qcol + 15)
                    ATT_CHUNK(krow + (size_t)(c4 + e) * (3 * D), (ATT_KC >= wst && ATT_KC < wst + 16), rpi[ATT_DC < 0 ? 0 : (ATT_DC > 30 ? 30 : ATT_DC)]);
#undef ATT_KC
#undef ATT_DC
                }
            }
        }
        const float inv = 1.0f / l;
        bf16* op = O + (size_t)qrow * D + h * HD + ds * 32;
#pragma unroll
        for (int i = 0; i < 4; ++i) { v4u w; w.x = pk2(acc[8 * i + 0] * inv, acc[8 * i + 1] * inv); w.y = pk2(acc[8 * i + 2] * inv, acc[8 * i + 3] * inv);
            w.z = pk2(acc[8 * i + 4] * inv, acc[8 * i + 5] * inv); w.w = pk2(acc[8 * i + 6] * inv, acc[8 * i + 7] * inv); *(v4u*)(op + 8 * i) = w; }
    }
}

constexpr int NPHASE = 3 + 7 * DEPTH;
__global__ void __launch_bounds__(NWAVES * 64, 2) fwd(Args args) {
    extern __shared__ __attribute__((aligned(16))) unsigned char lds[];
    Frame F;
    F.lds = (LAS unsigned char*)lds;
    F.MISC = (volatile LAS unsigned*)(F.lds + MISC_OFF);
    F.tid = threadIdx.x; F.lane = F.tid & 63; F.wave = __builtin_amdgcn_readfirstlane(F.tid >> 6);
    F.G = gridDim.x; { const int bx = blockIdx.x; F.vcu = (F.G % 8 == 0) ? (bx % 8) * (F.G / 8) + bx / 8 : bx; }
    unsigned char* ws = args.ws;
    F.ctl = (gu32*)(ws + WS_CTL);
    for (int u = F.tid; u < (LDS_BYTES - LDSCTL_OFF) / 4; u += NWAVES * 64) ((LAS unsigned*)(F.lds + LDSCTL_OFF))[u] = 0u;
    __syncthreads();
    const int lo = args.ph_lo, hi = args.ph_hi;
    const bool multi = (hi - lo) > 1;
    XcdBarrier bar; bar.bar = (unsigned*)(F.ctl + CW_BAR); bar.x = 0; bar.st = nullptr;
    if (multi) bar = xcd_barrier_post((unsigned*)(F.ctl + CW_BAR), F.MISC + 8);
#define IN(k) (lo <= (k) && (k) < hi)
#define SEAM(k) do { if (IN((k) + 1)) xcd_barrier(bar); } while (0)

    float* const X = (float*)(ws + WS_X);
    const float* const ADA = (const float*)(ws + WS_ADA);
    bf16* const H = (bf16*)(ws + WS_H);

    if (IN(0)) { p_ada_partial(F, args); __syncthreads(); p_convert_weights(F, args); p_copy_x(F, args); SEAM(0); }
    if (IN(1)) { p_ada_reduce(F, args); SEAM(1); }
    if (IN(2)) { p_modulate(F, args, MR, ADA, 0, D); SEAM(2); }

    for (int l = 0; l < DEPTH; ++l) {
        const int pb = 3 + 7 * l;
        const bool use_na = (l & 1) == 0; const int j = l >> 1;
        const int rows = l < 2 ? MR : ML;
        const float* ada_l = ADA + (size_t)l * NCOND * ADAW;
        if (use_na) {
            if (IN(pb + 0)) {
                pg8::Gemm g{H, (const bf16*)(ws + WS_WQKV) + (size_t)j * 3 * D * D, MR, 3 * D, D, D, D, 0, 0}; pg8::StaticOrder S; S.init(MR, 3 * D, F.G, (int)blockIdx.x);
                pg8::EpiBf16 E{(bf16*)(ws + WS_QKV), 3 * D};
                pg8::gemm_phase<pg8::EpiBf16, pg8::StaticOrder, true, true>(F.lds + RING_OFF, g, S, E);
                SEAM(pb + 0);
            }
            if (IN(pb + 1)) { p_attention_valu(F, args, args.na_rpb + (size_t)j * NH * 15 * 31, l == 0); SEAM(pb + 1); }
        } else {
            if (IN(pb + 0)) { p_pool(F, args, rows, ada_l); SEAM(pb + 0); }
        }
        if (IN(pb + 2)) {
            pg8::Gemm g; pg8::EpiRes E{X, D, ada_l + 2 * D, ADAW, nullptr, DN_ALPHA};
            if (use_na) g = pg8::Gemm{(const bf16*)(ws + WS_O), (const bf16*)(ws + WS_WO) + (size_t)j * D * D, rows, D, D, D, D, 0, 0};
            else { g = pg8::Gemm{(const bf16*)(ws + WS_O), (const bf16*)(ws + WS_WPOOL) + (size_t)j * D * 512, rows, D, 512, D, 512, 2, 512}; E.colscale = args.pool_scale + (size_t)j * D; }
            pg8::StaticOrder S; S.init(rows, D, F.G, (int)blockIdx.x);
            pg8::gemm_phase<pg8::EpiRes, pg8::StaticOrder, true, true>(F.lds + RING_OFF, g, S, E);
            SEAM(pb + 2);
        }
        if (IN(pb + 3)) { p_layernorm(F, args, rows, args.ln_mix_g + (size_t)l * D, args.ln_mix_b + (size_t)l * D, X, ada_l, 3 * D, 4 * D); SEAM(pb + 3); }
        if (IN(pb + 4)) {
            pg8::Gemm g{H, (const bf16*)(ws + WS_WIN) + (size_t)l * 2 * DFF * D, rows, 2 * DFF, D, D, D, 0, 0}; pg8::StaticOrder S; S.init(rows, 2 * DFF, F.G, (int)blockIdx.x);
            pg8::EpiSwiGLU E{(bf16*)(ws + WS_ACT), DFF};
            pg8::gemm_phase<pg8::EpiSwiGLU, pg8::StaticOrder, true, true>(F.lds + RING_OFF, g, S, E);
            SEAM(pb + 4);
        }
        if (IN(pb + 5)) {
            pg8::Gemm g{(const bf16*)(ws + WS_ACT), (const bf16*)(ws + WS_WOUT) + (size_t)l * D * DFF, rows, D, DFF, DFF, DFF, 0, 0}; pg8::StaticOrder S; S.init(rows, D, F.G, (int)blockIdx.x);
            pg8::EpiRes E{X, D, ada_l + 5 * D, ADAW, nullptr, DN_ALPHA};
            pg8::gemm_phase<pg8::EpiRes, pg8::StaticOrder, true, true>(F.lds + RING_OFF, g, S, E);
            SEAM(pb + 5);
        }
        if (IN(pb + 6)) {
            const bool last = (l == DEPTH - 1);
            const int nrows = l < 2 ? MR : ML;
            p_layernorm(F, args, nrows, args.ln_ffn_g + (size_t)l * D, args.ln_ffn_b + (size_t)l * D, last ? args.out : X, last ? nullptr : ada_l + (size_t)NCOND * ADAW, 0, D);
            if (!last) SEAM(pb + 6);
        }
    }
#undef IN
#undef SEAM
}

extern "C" void kernel_launch(void* const* d_in, const int* in_sizes, int n_in, void* d_out, int out_size, void* d_ws, size_t ws_size, hipStream_t stream) {
    static int grid = 0;
    if (grid == 0) {
        if (n_in != 17 || out_size != ML * D || ws_size < WS_END) { fprintf(stderr, "kernel_launch: unexpected shapes (n_in %d, out %d, ws %zu); nothing launched\n", n_in, out_size, ws_size); grid = -1; return; }
        int dev = 0, cus = 0, per_cu = 0;
        if (hipGetDevice(&dev) != hipSuccess || hipDeviceGetAttribute(&cus, hipDeviceAttributeMultiprocessorCount, dev) != hipSuccess) { grid = -1; return; }
        if (hipFuncSetAttribute((const void*)fwd, hipFuncAttributeMaxDynamicSharedMemorySize, LDS_BYTES) != hipSuccess) { fprintf(stderr, "kernel_launch: hipFuncSetAttribute failed\n"); grid = -1; return; }
        if (hipOccupancyMaxActiveBlocksPerMultiprocessor(&per_cu, (const void*)fwd, NWAVES * 64, LDS_BYTES) != hipSuccess || per_cu < 1)
            fprintf(stderr, "kernel_launch: note: occupancy query reports %d workgroups per CU\n", per_cu);
        (void)hipGetLastError();
        grid = cus;
    }
    if (grid < 0) return;
    if (hipMemsetAsync((char*)d_ws + WS_CTL, 0, CTL_ZERO_BYTES, stream) != hipSuccess) { fprintf(stderr, "kernel_launch: memset failed\n"); return; }
    Args a{};
    a.x = (const float*)d_in[0]; a.c = (const float*)d_in[1]; a.ctx = (const float*)d_in[2]; a.c_ctx = (const float*)d_in[3]; a.ada_w = (const float*)d_in[4]; a.ada_b = (const float*)d_in[5];
    a.ln_mix_g = (const float*)d_in[6]; a.ln_mix_b = (const float*)d_in[7]; a.ln_ffn_g = (const float*)d_in[8]; a.ln_ffn_b = (const float*)d_in[9];
    a.na_w_qkv = (const float*)d_in[10]; a.na_w_o = (const float*)d_in[11]; a.na_rpb = (const float*)d_in[12]; a.pool_w = (const float*)d_in[13]; a.pool_scale = (const float*)d_in[14];
    a.ffn_w_in = (const float*)d_in[15]; a.ffn_w_out = (const float*)d_in[16];
    a.out = (float*)d_out; a.ws = (unsigned char*)d_ws;
#if MK_ONE_LAUNCH
    a.ph_lo = 0; a.ph_hi = NPHASE;
    hipLaunchKernelGGL(fwd, dim3(grid), dim3(NWAVES * 64), LDS_BYTES, stream, a);
#else
    for (int p = 0; p < NPHASE; ++p) {
        const int l = (p - 3) / 7, s = (p - 3) % 7;
        if (p >= 3 && (l & 1) == 1 && s == 1) continue;
        a.ph_lo = p; a.ph_hi = p + 1;
        hipLaunchKernelGGL(fwd, dim3(grid), dim3(NWAVES * 64), LDS_BYTES, stream, a);
    }
#endif
    const hipError_t le = hipPeekAtLastError();
    if (le != hipSuccess) fprintf(stderr, "kernel_launch: launch failed: %s\n", hipGetErrorName(le));
}
```

```cpp
#include <hip/hip_runtime.h>
#include <cstdio>
#include <cstdint>

#ifndef MK_ONE_LAUNCH
#define MK_ONE_LAUNCH 1
#endif

namespace pg8 {
#define PG8_LAS __attribute__((address_space(3)))
typedef unsigned short bf16_t;
typedef short bf16x8 __attribute__((ext_vector_type(8)));
typedef float f32x4 __attribute__((ext_vector_type(4)));
typedef unsigned u32x4 __attribute__((ext_vector_type(4)));
constexpr int BM = 256, BK = 64, HALF = 128, HTB = HALF * BK * 2  , STAGE_BYTES = 8 * HTB, NXCD = 8, WGM = 8;

__host__ __device__ __forceinline__ int lds_byte(int r, int c) { const int st = (r >> 4) * 2 + (c >> 5), rr = r & 15, cc = c & 31, ob = rr * 64 + cc * 2; return st * 1024 + (ob ^ (((ob >> 9) & 1) << 5)); }
__host__ __device__ __forceinline__ void stage_rc(int b, int& R, int& C) { const int st = b / 1024, sb = b % 1024, swz = sb ^ (((sb >> 9) & 1) << 5); R = (st >> 1) * 16 + swz / 64; C = (st & 1) * 32 + (swz % 64) / 2; }
__host__ __device__ __forceinline__ int perm32(int rho) { const int n = rho >> 4, i = rho & 15; return 8 * (i >> 2) + 4 * n + (i & 3); }

__device__ __forceinline__ int opaque_v(int v) { asm volatile("" : "+v"(v)); return v; }
struct Unit { int pm, pn; };
struct Gemm { const bf16_t* A; const bf16_t* Bt; int M, N, K, lda, ldb, grp_pn, grp_k; };

struct StaticOrder {
    int nM, nN, nwg, G, c;
    __host__ __device__ void init(int M, int N, int G_, int c_) { nM = M / BM; nN = N / BM; nwg = nM * nN; G = G_; c = c_; }
    __host__ __device__ bool next(int i, Unit& u) const {
        const long L = (long)i * G + c; if (L >= nwg) return false;
        int wgid = (int)L; { const int q = nwg / NXCD, r = nwg % NXCD, xcd = wgid % NXCD, off = wgid / NXCD; wgid = (xcd < r ? xcd * (q + 1) : r * (q + 1) + (xcd - r) * q) + off; }
        const int nig = WGM * nN, gid = wgid / nig, fm = gid * WGM, gsz = (nM - fm) < WGM ? (nM - fm) : WGM;
        u.pm = fm + ((wgid % nig) % gsz); u.pn = (wgid % nig) / gsz; return true;
    }
    __device__ __forceinline__ void a_ready(const Unit&) const {}
    __device__ __forceinline__ void done(const Unit&) const {}
};

__device__ __forceinline__ unsigned cvt_pk_bf16(float lo, float hi) { unsigned r; asm volatile("v_cvt_pk_bf16_f32 %0, %1, %2" : "=v"(r) : "v"(lo), "v"(hi)); return r; }

struct EpiBf16 {
    static constexpr bool PERM = true, AFTER_DRAIN = false;
    bf16_t* O; int ldc;
    __device__ __forceinline__ void operator()(const f32x4 (&acc)[2][2][4][2], const Unit& u, int wr, int wc, int fr, int fq) const {
        const int row0 = u.pm * BM + wr * 64 + fr; const int col0 = u.pn * BM + wc * 32 + 8 * fq;
#pragma unroll
        for (int ai = 0; ai < 2; ++ai)
#pragma unroll
            for (int m = 0; m < 4; ++m) { bf16_t* rowp = O + (size_t)(row0 + ai * HALF + m * 16) * ldc + col0;
#pragma unroll
                for (int bj = 0; bj < 2; ++bj) { const f32x4 v0 = acc[ai][bj][m][0], v1 = acc[ai][bj][m][1];
                    u32x4 w; w.x = cvt_pk_bf16(v0[0], v0[1]); w.y = cvt_pk_bf16(v0[2], v0[3]); w.z = cvt_pk_bf16(v1[0], v1[1]); w.w = cvt_pk_bf16(v1[2], v1[3]);
                    *(u32x4*)(rowp + bj * HALF) = w; } }
    }
};
struct EpiSwiGLU {
    static constexpr bool PERM = true, AFTER_DRAIN = false;
    bf16_t* O; int ldc;
    __device__ __forceinline__ float act(float g, float u) const { return g * u * __builtin_amdgcn_rcpf(1.0f + __builtin_amdgcn_exp2f(g * -1.44269504089f)); }
    __device__ __forceinline__ void operator()(const f32x4 (&acc)[2][2][4][2], const Unit& u, int wr, int wc, int fr, int fq) const {
        const int row0 = u.pm * BM + wr * 64 + fr; const int col0 = u.pn * HALF + wc * 32 + 8 * fq;
#pragma unroll
        for (int ai = 0; ai < 2; ++ai)
#pragma unroll
            for (int m = 0; m < 4; ++m) { bf16_t* rowp = O + (size_t)(row0 + ai * HALF + m * 16) * ldc + col0;
                const f32x4 g0 = acc[ai][0][m][0], g1 = acc[ai][0][m][1], u0 = acc[ai][1][m][0], u1 = acc[ai][1][m][1];
                u32x4 w; w.x = cvt_pk_bf16(act(g0[0], u0[0]), act(g0[1], u0[1])); w.y = cvt_pk_bf16(act(g0[2], u0[2]), act(g0[3], u0[3]));
                w.z = cvt_pk_bf16(act(g1[0], u1[0]), act(g1[1], u1[1])); w.w = cvt_pk_bf16(act(g1[2], u1[2]), act(g1[3], u1[3]));
                *(u32x4*)rowp = w; }
    }
};
struct EpiRes {
    static constexpr bool PERM = false, AFTER_DRAIN = false;
    float* X; float* Xo; int ldx; const float* gate; int gate_stride; const float* colscale; float alpha;
    __device__ __forceinline__ void operator()(const f32x4 (&acc)[2][2][4][2], const Unit& u, int wr, int wc, int fr, int fq) const {
        const int row0 = u.pm * BM + wr * 64 + fr, col0 = u.pn * BM + wc * 32 + 4 * fq;
        const int cond = u.pm < 64 ? (u.pm >> 4) : 4;
        const float* gp = gate + (size_t)cond * gate_stride + col0;
        f32x4 gv[2][2];
#pragma unroll
        for (int bj = 0; bj < 2; ++bj)
#pragma unroll
            for (int n = 0; n < 2; ++n) { gv[bj][n] = *(const f32x4*)(gp + bj * HALF + n * 16); if (colscale) gv[bj][n] = gv[bj][n] * *(const f32x4*)(colscale + col0 + bj * HALF + n * 16); }
#pragma unroll
        for (int ai = 0; ai < 2; ++ai)
#pragma unroll
            for (int m = 0; m < 4; ++m) { const size_t ro = (size_t)(row0 + ai * HALF + m * 16) * ldx + col0; const float* rowp = X + ro; float* rowo = Xo + ro;
#pragma unroll
                for (int bj = 0; bj < 2; ++bj)
#pragma unroll
                    for (int n = 0; n < 2; ++n) { const f32x4 xv = *(const f32x4*)(rowp + bj * HALF + n * 16); *(f32x4*)(rowo + bj * HALF + n * 16) = xv * alpha + gv[bj][n] * acc[ai][bj][m][n]; }
                asm volatile("" ::: "memory"); }
    }
};

template <class Epi, class Sched, bool ALIGN_EPI = false, bool SP2 = false>
__device__ __forceinline__ void gemm_phase(PG8_LAS unsigned char* lds, const Gemm g, const Sched& S, const Epi& E) {
    const int tid = opaque_v(threadIdx.x), wid = __builtin_amdgcn_readfirstlane(tid >> 6), lane = tid & 63, wr = wid >> 2, wc = wid & 3, fr = lane & 15, fq = lane >> 4;
    const int K = g.K, nt = K / BK;
    unsigned voffA[2], voffB[2];
#pragma unroll
    for (int i = 0; i < 2; ++i) { int R, C; stage_rc(tid * 16 + i * 8192, R, C); const int Rb = Epi::PERM ? ((R & ~31) + perm32(R & 31)) : R;
        voffA[i] = (unsigned)(R * g.lda + C) * 2u; voffB[i] = (unsigned)(Rb * g.ldb + C) * 2u; }
    const size_t kstep = (size_t)(BK * 2);
    const size_t hstepA = (size_t)HALF * g.lda * 2, hstepB = (size_t)HALF * g.ldb * 2;
    const size_t tstepA = 2 * hstepA, tstepB = 2 * hstepB;
    const unsigned ldsw = (unsigned)wid * 1024u;
    const int aoff = lds_byte(wr * 64 + fr, fq * 8), boff = lds_byte(wc * 32 + fr, fq * 8);
#define PG8_SA(b, h) (((b) * 2 + (h)) * HTB)
#define PG8_SB(b, h) ((4 + (b) * 2 + (h)) * HTB)
#define PG8_STAGE(bufoff, gbase, voff) do { _Pragma("unroll") for (int _i = 0; _i < 2; ++_i) \
        __builtin_amdgcn_global_load_lds((const unsigned*)((const char*)(gbase) + (voff)[_i]), (PG8_LAS unsigned*)(lds + (bufoff) + ldsw + _i * 8192), 16, 0, 0); } while (0)
#define PG8_LDA(dst, b, h) do { _Pragma("unroll") for (int m = 0; m < 4; ++m) _Pragma("unroll") for (int k = 0; k < 2; ++k) dst[m][k] = *(const PG8_LAS bf16x8*)(lds + PG8_SA(b, h) + aoff + m * 2048 + k * 1024); } while (0)
#define PG8_LDB(dst, b, h) do { _Pragma("unroll") for (int n = 0; n < 2; ++n) _Pragma("unroll") for (int k = 0; k < 2; ++k) dst[n][k] = *(const PG8_LAS bf16x8*)(lds + PG8_SB(b, h) + boff + n * 2048 + k * 1024); } while (0)
#define PG8_MMA(ai, bj, At, Bt) do { __builtin_amdgcn_s_setprio(1); _Pragma("unroll") for (int m = 0; m < 4; ++m) _Pragma("unroll") for (int n = 0; n < 2; ++n) _Pragma("unroll") for (int k = 0; k < 2; ++k) \
        acc[ai][bj][m][n] = __builtin_amdgcn_mfma_f32_16x16x32_bf16(Bt[n][k], At[m][k], acc[ai][bj][m][n], 0, 0, 0); __builtin_amdgcn_s_setprio(0); } while (0)
#define PG8_WAIT_V(n) asm volatile("s_waitcnt vmcnt(" #n ")" ::: "memory")
#define PG8_WAIT_L(n) asm volatile("s_waitcnt lgkmcnt(" #n ")" ::: "memory")
#define PG8_BAR __builtin_amdgcn_s_barrier()
#define PG8_SCHED __builtin_amdgcn_sched_barrier(0)
#define PG8_AOF(u) ((size_t)(u).pm * tstepA + (g.grp_pn ? (size_t)((u).pn / g.grp_pn) * (size_t)g.grp_k * 2 : (size_t)0))
    Unit cur, nxt; int ui = 0;
    if (!S.next(0, cur)) return;
    f32x4 acc[2][2][4][2];
#pragma unroll
    for (int a = 0; a < 2; ++a)
#pragma unroll
        for (int b = 0; b < 2; ++b)
#pragma unroll
            for (int m = 0; m < 4; ++m)
#pragma unroll
                for (int n = 0; n < 2; ++n) acc[a][b][m][n] = (f32x4){0.f, 0.f, 0.f, 0.f};
    bf16x8 At[4][2], B0[2][2], B1[2][2];
    const char* cA = (const char*)g.A + PG8_AOF(cur); const char* cB = (const char*)g.Bt + (size_t)cur.pn * tstepB;
    S.a_ready(cur);
    if constexpr (SP2) {
        PG8_STAGE(PG8_SB(0, 0), cB, voffB); PG8_STAGE(PG8_SB(0, 1), cB + hstepB, voffB); PG8_STAGE(PG8_SA(0, 0), cA, voffA); PG8_STAGE(PG8_SA(0, 1), cA + hstepA, voffA);
        if (wr == 1) PG8_BAR;
        PG8_WAIT_V(2); PG8_BAR;
        PG8_STAGE(PG8_SB(1, 0), cB + kstep, voffB); PG8_STAGE(PG8_SA(1, 0), cA + kstep, voffA); PG8_STAGE(PG8_SB(1, 1), cB + hstepB + kstep, voffB);
        PG8_WAIT_V(6); PG8_BAR;
    } else {
        PG8_STAGE(PG8_SB(0, 0), cB, voffB); PG8_STAGE(PG8_SA(0, 0), cA, voffA); PG8_STAGE(PG8_SB(0, 1), cB + hstepB, voffB); PG8_STAGE(PG8_SA(0, 1), cA + hstepA, voffA);
        if (wr == 1) PG8_BAR;
        PG8_WAIT_V(4); PG8_BAR;
        PG8_STAGE(PG8_SB(1, 0), cB + kstep, voffB); PG8_STAGE(PG8_SA(1, 0), cA + kstep, voffA); PG8_STAGE(PG8_SB(1, 1), cB + hstepB + kstep, voffB);
        PG8_WAIT_V(6); PG8_BAR;
    }
    for (;;) {
        const bool has_next = S.next(ui + 1, nxt);
        const char* nA = has_next ? (const char*)g.A + PG8_AOF(nxt) : cA; const char* nB = has_next ? (const char*)g.Bt + (size_t)nxt.pn * tstepB : cB;
        for (int t = 0; t < nt; t += 2) {
            const bool last = (t == nt - 2);
            const char* a1 = cA + (size_t)(t + 1) * kstep;
            const char* a2 = last ? nA : cA + (size_t)(t + 2) * kstep; const char* b2 = last ? nB : cB + (size_t)(t + 2) * kstep;
            const char* a3 = a2 + kstep; const char* b3 = b2 + kstep;
            if (last && has_next) S.a_ready(nxt);
            if constexpr (SP2) {
            PG8_LDB(B0, 0, 0); PG8_LDB(B1, 0, 1); PG8_SCHED; PG8_LDA(At, 0, 0); PG8_STAGE(PG8_SA(1, 1), a1 + hstepA, voffA);
            PG8_WAIT_V(8); PG8_WAIT_L(0); PG8_BAR; PG8_MMA(0, 0, At, B0); PG8_MMA(0, 1, At, B1); PG8_BAR; PG8_SCHED;
            PG8_LDA(At, 0, 1); PG8_STAGE(PG8_SB(0, 0), b2, voffB); PG8_STAGE(PG8_SB(0, 1), b2 + hstepB, voffB); PG8_STAGE(PG8_SA(0, 0), a2, voffA);
            PG8_WAIT_V(8); PG8_WAIT_L(0); PG8_BAR; PG8_MMA(1, 0, At, B0); PG8_MMA(1, 1, At, B1); PG8_BAR; PG8_SCHED;
            PG8_LDB(B0, 1, 0); PG8_LDB(B1, 1, 1); PG8_SCHED; PG8_LDA(At, 1, 0); PG8_STAGE(PG8_SA(0, 1), a2 + hstepA, voffA);
            PG8_WAIT_V(8); PG8_WAIT_L(0); PG8_BAR; PG8_MMA(0, 0, At, B0); PG8_MMA(0, 1, At, B1); PG8_BAR; PG8_SCHED;
            PG8_LDA(At, 1, 1); PG8_STAGE(PG8_SB(1, 0), b3, voffB); PG8_STAGE(PG8_SB(1, 1), b3 + hstepB, voffB); PG8_STAGE(PG8_SA(1, 0), a3, voffA);
            PG8_WAIT_V(8); PG8_WAIT_L(0); PG8_BAR; PG8_MMA(1, 0, At, B0); PG8_MMA(1, 1, At, B1); PG8_BAR; PG8_SCHED;
            } else {
            PG8_LDB(B0, 0, 0); PG8_SCHED; PG8_LDA(At, 0, 0); PG8_STAGE(PG8_SA(1, 1), a1 + hstepA, voffA);
            PG8_WAIT_L(8); PG8_BAR; PG8_WAIT_L(0); PG8_MMA(0, 0, At, B0); PG8_BAR; PG8_SCHED;
            PG8_LDB(B1, 0, 1); PG8_STAGE(PG8_SB(0, 0), b2, voffB);
            PG8_BAR; PG8_WAIT_L(0); PG8_MMA(0, 1, At, B1); PG8_BAR;
            PG8_LDA(At, 0, 1); PG8_STAGE(PG8_SA(0, 0), a2, voffA);
            PG8_BAR; PG8_WAIT_L(0); PG8_MMA(1, 0, At, B0); PG8_BAR; PG8_SCHED;
            PG8_STAGE(PG8_SB(0, 1), b2 + hstepB, voffB);
            PG8_WAIT_V(6); PG8_BAR; PG8_MMA(1, 1, At, B1); PG8_BAR;
            PG8_LDB(B0, 1, 0); PG8_SCHED; PG8_LDA(At, 1, 0); PG8_STAGE(PG8_SA(0, 1), a2 + hstepA, voffA);
            PG8_WAIT_L(8); PG8_BAR; PG8_WAIT_L(0); PG8_MMA(0, 0, At, B0); PG8_BAR; PG8_SCHED;
            PG8_LDB(B1, 1, 1); PG8_STAGE(PG8_SB(1, 0), b3, voffB);
            PG8_BAR; PG8_WAIT_L(0); PG8_MMA(0, 1, At, B1); PG8_BAR;
            PG8_LDA(At, 1, 1); PG8_STAGE(PG8_SA(1, 0), a3, voffA);
            PG8_BAR; PG8_WAIT_L(0); PG8_MMA(1, 0, At, B0); PG8_BAR; PG8_SCHED;
            PG8_STAGE(PG8_SB(1, 1), b3 + hstepB, voffB);
            PG8_WAIT_V(6); PG8_BAR; PG8_MMA(1, 1, At, B1); PG8_BAR;
            }
        }
        if constexpr (ALIGN_EPI) { if (wr == 0) PG8_BAR; }
        if constexpr (!Epi::AFTER_DRAIN) { E(acc, cur, wr, wc, fr, fq); S.done(cur); }
        if (!has_next) break;
#pragma unroll
        for (int a = 0; a < 2; ++a)
#pragma unroll
            for (int b = 0; b < 2; ++b)
#pragma unroll
                for (int m = 0; m < 4; ++m)
#pragma unroll
                    for (int n = 0; n < 2; ++n) acc[a][b][m][n] = (f32x4){0.f, 0.f, 0.f, 0.f};
        cur = nxt; cA = nA; cB = nB; ++ui;
        if constexpr (ALIGN_EPI) { if (wr == 1) PG8_BAR; }
    }
    PG8_WAIT_V(0);
    if constexpr (!ALIGN_EPI) { if (wr == 0) PG8_BAR; }
    PG8_BAR;
#undef PG8_AOF
#undef PG8_SA
#undef PG8_SB
#undef PG8_STAGE
#undef PG8_LDA
#undef PG8_LDB
#undef PG8_MMA
#undef PG8_WAIT_V
#undef PG8_WAIT_L
#undef PG8_BAR
#undef PG8_SCHED
}
}

constexpr int NWAVES = 8;
constexpr int D = 2048, BATCH = 4, SEQ = 4096, DEPTH = 4, CTXL = 256, GRIDW = 64, NH = 16, HD = 128;
constexpr int DFF = 5632, NADA = 6;
constexpr int ML = BATCH * SEQ;
constexpr int MC = BATCH * CTXL;
constexpr int MR = ML + MC;
constexpr int NCOND = BATCH + 1;
constexpr int ADAW = NADA * D;
constexpr float LN_EPS = 1e-5f;
constexpr float DN_ALPHA = 1.6817928305074290f;
constexpr float ATT_SCALE = 0.08838834764831845f;
constexpr int KSPLIT = 32;

constexpr size_t MiB = 1u << 20;
constexpr size_t WS_CTL = 0, CTL_ZERO_BYTES = 1 * MiB;
constexpr size_t WS_ADA = 1 * MiB;
constexpr size_t WS_PART = 2 * MiB;
constexpr size_t WS_WQKV = 34 * MiB;
constexpr size_t WS_WO = 82 * MiB;
constexpr size_t WS_WPOOL = 98 * MiB;
constexpr size_t WS_WIN = 102 * MiB;
constexpr size_t WS_WOUT = 278 * MiB;
constexpr size_t WS_X = 366 * MiB;
constexpr size_t WS_H = 502 * MiB;
constexpr size_t WS_QKV = 570 * MiB;
constexpr size_t WS_O = 774 * MiB;
constexpr size_t WS_ACT = 842 * MiB;
constexpr size_t WS_DUMX = 1030 * MiB;
constexpr size_t WS_DUMH = 1166 * MiB;
constexpr size_t WS_END = 1234 * MiB;
constexpr int CW_TMO = 0, CW_CODE = 1;
constexpr int CW_BAR = 4096;

constexpr int RING_OFF = 0, RING_BYTES = 131072;
constexpr int LDSCTL_OFF = RING_BYTES, MISC_OFF = LDSCTL_OFF + 320;
constexpr int LDS_BYTES = 147456;

#define GAS __attribute__((address_space(1)))
#define LAS __attribute__((address_space(3)))
typedef unsigned short bf16;
typedef unsigned v4u __attribute__((ext_vector_type(4)));
typedef unsigned v2u __attribute__((ext_vector_type(2)));
typedef float f32x4 __attribute__((ext_vector_type(4)));
typedef GAS unsigned gu32;
#define RLX_AGENT __ATOMIC_RELAXED, __HIP_MEMORY_SCOPE_AGENT
#define LDS_WAIT() asm volatile("s_waitcnt lgkmcnt(0)" ::: "memory")
#define VM_WAIT() asm volatile("s_waitcnt vmcnt(0)" ::: "memory")
__device__ __forceinline__ unsigned f2bf(float f) { unsigned u = __builtin_bit_cast(unsigned, f); return (u + 0x7fffu + ((u >> 16) & 1u)) >> 16; }
__device__ __forceinline__ unsigned pk2(float lo, float hi) { return f2bf(lo) | (f2bf(hi) << 16); }
__device__ __forceinline__ float bf_lo(unsigned w) { return __builtin_bit_cast(float, w << 16); }
__device__ __forceinline__ float bf_hi(unsigned w) { return __builtin_bit_cast(float, w & 0xffff0000u); }

#define XB_TMO      128
#define XB_XCNT(j)  (256  + 64 * (j))
#define XB_XSUB(j)  (1280 + 64 * (j))
#define XB_XGEN(j)  (2304 + 64 * (j))
#define XB_TOP      3328
#define XB_TOPGEN   3392
#define XCD_BAR_WORDS 3456
#define XB_SPIN_CAP (1u << 18)

__device__ __forceinline__ unsigned xb_ld(unsigned* p)              { return __hip_atomic_load(p, __ATOMIC_RELAXED, __HIP_MEMORY_SCOPE_AGENT); }
__device__ __forceinline__ unsigned xb_add(unsigned* p, unsigned v) { return __hip_atomic_fetch_add(p, v, __ATOMIC_RELAXED, __HIP_MEMORY_SCOPE_AGENT); }
__device__ __forceinline__ unsigned xb_xcc_id() { return (unsigned)__builtin_amdgcn_s_getreg((3 << 11) | 20) & 0xFu; }
#define XB_SPIN(cond, bar) do { unsigned _sp = 0; while (cond) { __builtin_amdgcn_s_sleep(1); \
    if ((++_sp & 255u) == 0u) { if (xb_ld(&(bar)[XB_TMO])) break; if (_sp > XB_SPIN_CAP) { atomicAdd(&(bar)[XB_TMO], 1u); break; } } } } while (0)

struct XcdBarrier { unsigned* bar; unsigned x; volatile LAS unsigned* st; };

__device__ __forceinline__ XcdBarrier xcd_barrier_post(unsigned* bar, volatile LAS unsigned* st) {
    XcdBarrier b; b.bar = bar; b.x = xb_xcc_id(); b.st = st;
    if (threadIdx.x == 0) (void)xb_add(&bar[XB_XCNT(b.x)], 1u);
    return b;
}
__device__ __forceinline__ void xcd_barrier_complete(unsigned* bar, unsigned x, unsigned& nloc, unsigned& nx) {
    const unsigned G = gridDim.x * gridDim.y * gridDim.z;
    unsigned sum, cnt, mine, sp = 0u;
    for (;;) {
        sum = 0u; cnt = 0u; mine = 0u;
#pragma unroll
        for (unsigned j = 0; j < 16; ++j) { const unsigned c = xb_ld(&bar[XB_XCNT(j)]); sum += c; cnt += (c > 0u) ? 1u : 0u; mine = (j == x) ? c : mine; }
        if (sum == G) break;
        __builtin_amdgcn_s_sleep(1);
        if ((++sp & 255u) == 0u) { if (xb_ld(&bar[XB_TMO])) break; if (sp > XB_SPIN_CAP) { atomicAdd(&bar[XB_TMO], 1u); break; } }
    }
    nloc = mine > 0u ? mine : 1u; nx = cnt > 0u ? cnt : 1u;
}
__device__ __forceinline__ void xcd_barrier(const XcdBarrier& b) {
    asm volatile("s_waitcnt vmcnt(0)" ::: "memory");
    __syncthreads();
    if (threadIdx.x == 0) {
        unsigned* bar = b.bar;
        __builtin_amdgcn_s_waitcnt(0);
        unsigned nloc = b.st[0], nx = b.st[1];
        if (nloc == 0u) { xcd_barrier_complete(bar, b.x, nloc, nx); b.st[0] = nloc; b.st[1] = nx; }
        const unsigned old = xb_add(&bar[XB_XSUB(b.x)], 1u);
        const unsigned gen = old / nloc;
        if (old + 1u == (gen + 1u) * nloc) {
            __builtin_amdgcn_fence(__ATOMIC_RELEASE, "agent");
            asm volatile("s_waitcnt vmcnt(0)" ::: "memory");
            const unsigned og = xb_add(&bar[XB_TOP], 1u);
            const unsigned tg = og / nx;
            if (og + 1u == (tg + 1u) * nx) xb_add(&bar[XB_TOPGEN], 1u);
            else XB_SPIN(xb_ld(&bar[XB_TOPGEN]) == tg, bar);
            __builtin_amdgcn_fence(__ATOMIC_ACQUIRE, "agent");
            xb_add(&bar[XB_XGEN(b.x)], 1u);
            asm volatile("s_waitcnt vmcnt(0)" ::: "memory");
        } else {
            XB_SPIN(xb_ld(&bar[XB_XGEN(b.x)]) == gen, bar);
            __builtin_amdgcn_fence(__ATOMIC_ACQUIRE, "agent");
            asm volatile("s_waitcnt vmcnt(0)" ::: "memory");
        }
    }
    __syncthreads();
}

struct Args {
    const float *x, *c, *ctx, *c_ctx, *ada_w, *ada_b, *ln_mix_g, *ln_mix_b, *ln_ffn_g, *ln_ffn_b, *na_w_qkv, *na_w_o, *na_rpb, *pool_w, *pool_scale, *ffn_w_in, *ffn_w_out;
    float* out; unsigned char* ws; int ph_lo, ph_hi;
};
struct Frame {
    LAS unsigned char* lds;
    volatile LAS unsigned* MISC;
    gu32* ctl;
    int tid, lane, wave;
    int vcu, G;
};

__device__ __forceinline__ float wave_sum(float v) {
#pragma unroll
    for (int o = 1; o < 64; o <<= 1) v += __shfl_xor(v, o);
    return v;
}
__device__ __forceinline__ float silu_f(float v) { return v / (1.0f + __expf(-v)); }

__device__ __forceinline__ void transpose_item(const float* W, int N, bf16* WT, int ldt, int drow0, LAS float* scr, int k0, int n0, int lane) {
#pragma unroll 8
    for (int i = 0; i < 32; ++i) { const int kk = 2 * i + (lane >> 5); scr[kk * 33 + (lane & 31)] = W[(size_t)(k0 + kk) * N + n0 + (lane & 31)]; }
    LDS_WAIT(); asm volatile("" ::: "memory");
    const int c = lane & 7;
#pragma unroll
    for (int j = 0; j < 4; ++j) { const int n = (lane >> 3) + 8 * j; const LAS float* s = scr + (8 * c) * 33 + n;
        v4u o; o.x = pk2(s[0 * 33], s[1 * 33]); o.y = pk2(s[2 * 33], s[3 * 33]); o.z = pk2(s[4 * 33], s[5 * 33]); o.w = pk2(s[6 * 33], s[7 * 33]);
        *(GAS v4u*)(WT + (size_t)(drow0 + n) * ldt + k0 + 8 * c) = o; }
    LDS_WAIT(); asm volatile("" ::: "memory");
}

__device__ __forceinline__ void p_convert_weights(Frame F, const Args& a) {
    F.tid = pg8::opaque_v(F.tid); F.lane = F.tid & 63;
    LAS float* scr = (LAS float*)(F.lds + RING_OFF + F.wave * 16384);
    const int gw = F.vcu * NWAVES + F.wave, NGW = F.G * NWAVES;
    unsigned char* ws = a.ws;
    constexpr int I_QKV = (D / 64) * (3 * D / 32), I_O = (D / 64) * (D / 32), I_POOL = (512 / 64) * (512 / 32), I_IN = (D / 64) * (2 * DFF / 32), I_OUT = (DFF / 64) * (D / 32);
    constexpr int T_QKV = 2 * I_QKV, T_O = 2 * I_O, T_POOL = 8 * I_POOL, T_IN = 4 * I_IN, T_OUT = 4 * I_OUT;
    constexpr int NITEMS = T_QKV + T_O + T_POOL + T_IN + T_OUT;
    for (int it = gw; it < NITEMS; it += NGW) {
        int r = it;
        if (r < T_QKV) { const int j = r / I_QKV, q = r % I_QKV, nblk = 3 * D / 32, kb = q / nblk, nb = q % nblk;
            transpose_item(a.na_w_qkv + (size_t)j * D * 3 * D, 3 * D, (bf16*)(ws + WS_WQKV) + (size_t)j * 3 * D * D, D, 32 * nb, scr, 64 * kb, 32 * nb, F.lane); continue; } r -= T_QKV;
        if (r < T_O) { const int j = r / I_O, q = r % I_O, nblk = D / 32, kb = q / nblk, nb = q % nblk;
            transpose_item(a.na_w_o + (size_t)j * D * D, D, (bf16*)(ws + WS_WO) + (size_t)j * D * D, D, 32 * nb, scr, 64 * kb, 32 * nb, F.lane); continue; } r -= T_O;
        if (r < T_POOL) { const int jg = r / I_POOL, q = r % I_POOL, nblk = 512 / 32, kb = q / nblk, nb = q % nblk;
            transpose_item(a.pool_w + (size_t)jg * 512 * 512, 512, (bf16*)(ws + WS_WPOOL) + (size_t)(jg >> 2) * D * 512, 512, (jg & 3) * 512 + 32 * nb, scr, 64 * kb, 32 * nb, F.lane); continue; } r -= T_POOL;
        if (r < T_IN) { const int l = r / I_IN, q = r % I_IN, nblk = 2 * DFF / 32, kb = q / nblk, nb = q % nblk; const int n0 = 32 * nb, bj = n0 / DFF, jj = n0 % DFF;
            transpose_item(a.ffn_w_in + (size_t)l * D * 2 * DFF, 2 * DFF, (bf16*)(ws + WS_WIN) + (size_t)l * 2 * DFF * D, D, 256 * (jj / 128) + 128 * bj + (jj % 128), scr, 64 * kb, n0, F.lane); continue; } r -= T_IN;
        { const int l = r / I_OUT, q = r % I_OUT, nblk = D / 32, kb = q / nblk, nb = q % nblk;
            transpose_item(a.ffn_w_out + (size_t)l * DFF * D, D, (bf16*)(ws + WS_WOUT) + (size_t)l * D * DFF, DFF, 32 * nb, scr, 64 * kb, 32 * nb, F.lane); }
    }
}
__device__ __forceinline__ void p_copy_x(Frame F, const Args& a) {
    F.tid = pg8::opaque_v(F.tid); F.lane = F.tid & 63;
    float* X = (float*)(a.ws + WS_X);
    const size_t n4l = (size_t)ML * D / 4, n4c = (size_t)MC * D / 4, stride = (size_t)F.G * 512;
    const f32x4* s0 = (const f32x4*)a.x; const f32x4* s1 = (const f32x4*)a.ctx; f32x4* d = (f32x4*)X;
    for (size_t i = (size_t)F.vcu * 512 + F.tid; i < n4l + n4c; i += stride) d[i] = i < n4l ? s0[i] : s1[i - n4l];
}
__device__ __forceinline__ void p_ada_partial(Frame F, const Args& a) {
    F.tid = pg8::opaque_v(F.tid); F.lane = F.tid & 63;
    LAS float* sc = (LAS float*)(F.lds + RING_OFF);
    float* PART = (float*)(a.ws + WS_PART);
    constexpr int NCC = ADAW / 2048, NITEMS = DEPTH * NCC * KSPLIT;
    for (int it = F.vcu; it < NITEMS; it += F.G) {
        const int kc = it % KSPLIT, cc = (it / KSPLIT) % NCC, l = it / (KSPLIT * NCC);
        __syncthreads();
        if (F.tid < NCOND * 64) { const int i = F.tid >> 6, k = kc * 64 + (F.tid & 63); const float v = i < BATCH ? a.c[i * D + k] : a.c_ctx[k]; sc[F.tid] = silu_f(v); }
        __syncthreads();
        const float* wp = a.ada_w + ((size_t)l * D + kc * 64) * ADAW + cc * 2048 + 4 * F.tid;
        f32x4 acc[NCOND];
#pragma unroll
        for (int i = 0; i < NCOND; ++i) acc[i] = (f32x4){0.f, 0.f, 0.f, 0.f};
#pragma unroll 8
        for (int k = 0; k < 64; ++k) { const f32x4 w = *(const f32x4*)(wp + (size_t)k * ADAW);
#pragma unroll
            for (int i = 0; i < NCOND; ++i) acc[i] += w * sc[i * 64 + k]; }
#pragma unroll
        for (int i = 0; i < NCOND; ++i) *(f32x4*)(PART + (((size_t)kc * DEPTH + l) * NCOND + i) * ADAW + cc * 2048 + 4 * F.tid) = acc[i];
    }
}
__device__ __forceinline__ void p_ada_reduce(Frame F, const Args& a) {
    F.tid = pg8::opaque_v(F.tid); F.lane = F.tid & 63;
    const float* PART = (const float*)(a.ws + WS_PART); float* ADA = (float*)(a.ws + WS_ADA);
    constexpr int N4 = DEPTH * NCOND * ADAW / 4;
    for (int i = F.vcu * 512 + F.tid; i < N4; i += F.G * 512) {
        const int col4 = i % (ADAW / 4), l = i / (NCOND * ADAW / 4);
        f32x4 s = *(const f32x4*)(a.ada_b + (size_t)l * ADAW + 4 * col4);
        for (int kc = 0; kc < KSPLIT; ++kc) s += *(const f32x4*)(PART + (size_t)kc * DEPTH * NCOND * ADAW + 4 * (size_t)i);
        *(f32x4*)(ADA + 4 * (size_t)i) = s;
    }
}
__device__ __forceinline__ void p_modulate(Frame F, const Args& a, int nrows, const float* ada_l, int sh_off, int sc_off) {
    F.tid = pg8::opaque_v(F.tid); F.lane = F.tid & 63;
    const float* X = (const float*)(a.ws + WS_X); bf16* H = (bf16*)(a.ws + WS_H);
    const int gw = F.vcu * NWAVES + F.wave, NGW = F.G * NWAVES;
    for (int r = gw; r < nrows; r += NGW) {
        const int cond = r < ML ? r / SEQ : BATCH; const float* ap = ada_l + (size_t)cond * ADAW;
#pragma unroll
        for (int j = 0; j < 8; ++j) { const int col = 4 * F.lane + 256 * j; const f32x4 v = *(const f32x4*)(X + (size_t)r * D + col), sh = *(const f32x4*)(ap + sh_off + col), sc = *(const f32x4*)(ap + sc_off + col);
            const f32x4 h = v * (sc + 1.0f) + sh; v2u o; o.x = pk2(h[0], h[1]); o.y = pk2(h[2], h[3]); *(v2u*)(H + (size_t)r * D + col) = o; }
    }
}
__device__ __forceinline__ void p_layernorm(Frame F, const Args& a, int nrows, const float* g, const float* b, float* outp, bf16* H, const float* ada_n, int sh_off, int sc_off) {
    F.tid = pg8::opaque_v(F.tid); F.lane = F.tid & 63;
    float* X = (float*)(a.ws + WS_X);
    const int gw = F.vcu * NWAVES + F.wave, NGW = F.G * NWAVES;
    for (int r = gw; r < nrows; r += NGW) {
        f32x4 v[8]; float s = 0.f;
#pragma unroll
        for (int j = 0; j < 8; ++j) { v[j] = *(const f32x4*)(X + (size_t)r * D + 4 * F.lane + 256 * j); s += (v[j][0] + v[j][1]) + (v[j][2] + v[j][3]); }
        const float mean = wave_sum(s) * (1.f / D); float s2 = 0.f;
#pragma unroll
        for (int j = 0; j < 8; ++j) { v[j] = v[j] - mean; s2 += (v[j][0] * v[j][0] + v[j][1] * v[j][1]) + (v[j][2] * v[j][2] + v[j][3] * v[j][3]); }
        const float rstd = 1.f / sqrtf(wave_sum(s2) * (1.f / D) + LN_EPS);
        const int cond = r < ML ? r / SEQ : BATCH;
#pragma unroll
        for (int j = 0; j < 8; ++j) { const int col = 4 * F.lane + 256 * j; const f32x4 y = v[j] * rstd * *(const f32x4*)(g + col) + *(const f32x4*)(b + col);
            *(f32x4*)(outp + (size_t)r * D + col) = y;
            if (ada_n) { const float* ap = ada_n + (size_t)cond * ADAW; const f32x4 h = y * (*(const f32x4*)(ap + sc_off + col) + 1.0f) + *(const f32x4*)(ap + sh_off + col);
                v2u o; o.x = pk2(h[0], h[1]); o.y = pk2(h[2], h[3]); *(v2u*)(H + (size_t)r * D + col) = o; } }
    }
}
__device__ __forceinline__ void p_pool(Frame F, const Args& a, int nrows, const float* ada_l) {
    F.tid = pg8::opaque_v(F.tid); F.lane = F.tid & 63;
    const float* X = (const float*)(a.ws + WS_X); bf16* P = (bf16*)(a.ws + WS_O);
    const int gw = F.vcu * NWAVES + F.wave, NGW = F.G * NWAVES;
    for (int r = gw; r < nrows; r += NGW) {
        int base, t, L, cond;
        if (r < ML) { cond = r / SEQ; base = cond * SEQ; t = r - base; L = SEQ; } else { const int q = r - ML; cond = BATCH; base = ML + (q / CTXL) * CTXL; t = q % CTXL; L = CTXL; }
        const float* ap = ada_l + (size_t)cond * ADAW + D;
#pragma unroll
        for (int j = 0; j < 8; ++j) { const int col = 4 * F.lane + 256 * j; const int w = 2 << (j >> 1);
            int lo = t - w / 2, hi = lo + w; lo = lo < 0 ? 0 : lo; hi = hi > L ? L : hi;
            f32x4 s = (f32x4){0.f, 0.f, 0.f, 0.f};
            for (int tt = lo; tt < hi; ++tt) s += *(const f32x4*)(X + (size_t)(base + tt) * D + col);
            const f32x4 xv = *(const f32x4*)(X + (size_t)r * D + col), sc = *(const f32x4*)(ap + col);
            const f32x4 p = (s * (1.0f / (float)(hi - lo)) - xv) * (sc + 1.0f);
            v2u o; o.x = pk2(p[0], p[1]); o.y = pk2(p[2], p[3]); *(v2u*)(P + (size_t)r * D + col) = o; }
    }
}

#define ATT_CHUNK(KEYPTR_EXPR, VALID_EXPR, BIAS_EXPR) do { \
    float s_[4]; v4u kk_[4][4]; \
    _Pragma("unroll") for (int e = 0; e < 4; ++e) { const bf16* kp_ = (KEYPTR_EXPR); _Pragma("unroll") for (int i = 0; i < 4; ++i) kk_[e][i] = *(const v4u*)(kp_ + 8 * i); } \
    _Pragma("unroll") for (int e = 0; e < 4; ++e) { float d_ = 0.f; \
        _Pragma("unroll") for (int i = 0; i < 4; ++i) { const v4u w_ = kk_[e][i]; \
            d_ += qf[8 * i + 0] * bf_lo(w_.x) + qf[8 * i + 1] * bf_hi(w_.x) + qf[8 * i + 2] * bf_lo(w_.y) + qf[8 * i + 3] * bf_hi(w_.y) \
                + qf[8 * i + 4] * bf_lo(w_.z) + qf[8 * i + 5] * bf_hi(w_.z) + qf[8 * i + 6] * bf_lo(w_.w) + qf[8 * i + 7] * bf_hi(w_.w); } \
        d_ += __shfl_xor(d_, 1); d_ += __shfl_xor(d_, 2); \
        s_[e] = (VALID_EXPR) ? d_ + (BIAS_EXPR) : -1e30f; } \
    const float cm_ = fmaxf(fmaxf(s_[0], s_[1]), fmaxf(s_[2], s_[3])); const float mn_ = fmaxf(m, cm_); const float rs_ = __expf(m - mn_); m = mn_; l *= rs_; \
    _Pragma("unroll") for (int i = 0; i < 32; ++i) acc[i] *= rs_; \
    _Pragma("unroll") for (int e = 0; e < 4; ++e) { const float p_ = (s_[e] > -1e29f) ? __expf(s_[e] - m) : 0.f; l += p_; const bf16* vp_ = (KEYPTR_EXPR) + D; \
        _Pragma("unroll") for (int i = 0; i < 4; ++i) { const v4u w_ = *(const v4u*)(vp_ + 8 * i); \
            acc[8 * i + 0] += p_ * bf_lo(w_.x); acc[8 * i + 1] += p_ * bf_hi(w_.x); acc[8 * i + 2] += p_ * bf_lo(w_.y); acc[8 * i + 3] += p_ * bf_hi(w_.y); \
            acc[8 * i + 4] += p_ * bf_lo(w_.z); acc[8 * i + 5] += p_ * bf_hi(w_.z); acc[8 * i + 6] += p_ * bf_lo(w_.w); acc[8 * i + 7] += p_ * bf_hi(w_.w); } } \
} while (0)

__device__ __forceinline__ void p_attention_valu(Frame F, const Args& a, const float* rpb, bool ctx_queries) {
    F.tid = pg8::opaque_v(F.tid); F.lane = F.tid & 63;
    const bf16* QKV = (const bf16*)(a.ws + WS_QKV); bf16* O = (bf16*)(a.ws + WS_O);
    const int gw = F.vcu * NWAVES + F.wave, NGW = F.G * NWAVES;
    const int q = F.lane >> 2, ds = F.lane & 3;
    constexpr int N_LAT = BATCH * 64 * 4 * NH, N_CTX = BATCH * (CTXL / 16) * NH;
    const int ntot = N_LAT + (ctx_queries ? N_CTX : 0);
    for (int u = gw; u < ntot; u += NGW) {
        const bool lat = u < N_LAT; int b, h, qrow, r = 0, j = 0, r0 = 0;
        if (lat) { h = u & 15; int t = u >> 4; j = t & 3; t >>= 2; r = t & 63; b = t >> 6; qrow = b * SEQ + r * GRIDW + j * 16 + q; r0 = r - 4; r0 = r0 < 0 ? 0 : (r0 > 56 ? 56 : r0); }
        else { int t = u - N_LAT; h = t & 15; t >>= 4; const int qb = t & 15; b = t >> 4; qrow = ML + b * CTXL + qb * 16 + q; }
        float qf[32], acc[32];
        { const bf16* qp = QKV + (size_t)qrow * (3 * D) + h * HD + ds * 32;
#pragma unroll
          for (int i = 0; i < 4; ++i) { const v4u w = *(const v4u*)(qp + 8 * i);
              qf[8 * i + 0] = bf_lo(w.x) * ATT_SCALE; qf[8 * i + 1] = bf_hi(w.x) * ATT_SCALE; qf[8 * i + 2] = bf_lo(w.y) * ATT_SCALE; qf[8 * i + 3] = bf_hi(w.y) * ATT_SCALE;
              qf[8 * i + 4] = bf_lo(w.z) * ATT_SCALE; qf[8 * i + 5] = bf_hi(w.z) * ATT_SCALE; qf[8 * i + 6] = bf_lo(w.w) * ATT_SCALE; qf[8 * i + 7] = bf_hi(w.w) * ATT_SCALE; } }
#pragma unroll
        for (int i = 0; i < 32; ++i) acc[i] = 0.f;
        float m = -1e30f, l = 0.f;
        const bf16* kc_base = QKV + (size_t)(ML + b * CTXL) * (3 * D) + D + h * HD + ds * 32;
        for (int k0 = 0; k0 < CTXL; k0 += 4) { ATT_CHUNK(kc_base + (size_t)(k0 + e) * (3 * D), true, 0.f); }
        if (lat) {
            const int qcol = j * 16 + q; int wst = qcol - 8; wst = wst < 0 ? 0 : (wst > 48 ? 48 : wst);
            int bs = j * 16 - 8; bs = bs < 0 ? 0 : (bs > 32 ? 32 : bs);
            const float* rp = rpb + (size_t)h * 15 * 31;
            for (int i = 0; i < 8; ++i) {
                const bf16* krow = QKV + (size_t)(b * SEQ + (r0 + i) * GRIDW + bs) * (3 * D) + D + h * HD + ds * 32;
                const float* rpi = rp + (r0 + i - r + 7) * 31;
                for (int c4 = 0; c4 < 32; c4 += 4) {
#define ATT_KC (bs + c4 + e)
#define ATT_DC (ATT_KC - qcol + 15)
                    ATT_CHUNK(krow + (size_t)(c4 + e) * (3 * D), (ATT_KC >= wst && ATT_KC < wst + 16), rpi[ATT_DC < 0 ? 0 : (ATT_DC > 30 ? 30 : ATT_DC)]);
#undef ATT_KC
#undef ATT_DC
                }
            }
        }
        const float inv = 1.0f / l;
        bf16* op = O + (size_t)qrow * D + h * HD + ds * 32;
#pragma unroll
        for (int i = 0; i < 4; ++i) { v4u w; w.x = pk2(acc[8 * i + 0] * inv, acc[8 * i + 1] * inv); w.y = pk2(acc[8 * i + 2] * inv, acc[8 * i + 3] * inv);
            w.z = pk2(acc[8 * i + 4] * inv, acc[8 * i + 5] * inv); w.w = pk2(acc[8 * i + 6] * inv, acc[8 * i + 7] * inv); *(v4u*)(op + 8 * i) = w; }
    }
}

typedef short att_s4 __attribute__((ext_vector_type(4)));
typedef short att_s8 __attribute__((ext_vector_type(8)));
constexpr int ATT_TAB_OFF = 65536;
__device__ __forceinline__ void p_attention_mfma(Frame F, const Args& a, const float* rpb, bool ctx_queries) {
    F.tid = pg8::opaque_v(F.tid); F.lane = F.tid & 63;
    const bf16* QKV = (const bf16*)(a.ws + WS_QKV); bf16* O = (bf16*)(a.ws + WS_O);
    LAS unsigned char* lds = F.lds + RING_OFF;
    LAS float* tab = (LAS float*)(lds + ATT_TAB_OFF);
    const int tid = F.tid, lane = F.lane, wave = F.wave, i16 = lane & 15, g = lane >> 4;
    constexpr int NU_LAT = BATCH * NH * 32, NU_CTX = BATCH * NH * 2;
    constexpr float L2E = 1.44269504089f, C1 = ATT_SCALE * L2E;
    const int nu = NU_LAT + (ctx_queries ? NU_CTX : 0);
    const int ch = tid & 15, key0 = tid >> 4;
    const int kw = key0 * 256 + ((ch ^ (key0 & 15)) * 16), vw = 16384 + key0 * 256 + (((ch >> 1) ^ (key0 & 7)) * 32) + (ch & 1) * 16;
    for (int u = F.vcu; u < nu; u += F.G) {
        const bool lat = u < NU_LAT;
        int b, h, qrow, r_w = 0, j = 0, kr_lo = 0, nlat = 0;
        if (lat) { const int rp = u & 31; h = (u >> 5) & 15; b = u >> 9; r_w = 2 * rp + (wave >> 2); j = wave & 3; qrow = b * SEQ + r_w * GRIDW + j * 16 + i16;
            int lo = 2 * rp - 4; lo = lo < 0 ? 0 : (lo > 56 ? 56 : lo); int hi = 2 * rp - 3; hi = hi < 0 ? 0 : (hi > 56 ? 56 : hi); kr_lo = lo; nlat = hi + 8 - lo; }
        else { const int t = u - NU_LAT; h = (t >> 1) & 15; b = t >> 5; qrow = ML + b * CTXL + (t & 1) * 128 + wave * 16 + i16; }
        int r0w = r_w - 4; r0w = r0w < 0 ? 0 : (r0w > 56 ? 56 : r0w);
        const int ntiles = nlat + CTXL / 64;
        const size_t hoff = (size_t)h * HD + ch * 8;
        __syncthreads();
        if (lat && tid < 15 * 31) tab[tid] = rpb[(size_t)h * 15 * 31 + tid] * L2E;
        att_s8 qf[4];
        { const bf16* qp = QKV + (size_t)qrow * (3 * D) + h * HD + 8 * g;
#pragma unroll
          for (int st = 0; st < 4; ++st) qf[st] = *(const att_s8*)(qp + 32 * st); }
        f32x4 o[8];
#pragma unroll
        for (int dt = 0; dt < 8; ++dt) o[dt] = (f32x4){0.f, 0.f, 0.f, 0.f};
        float m = -1e30f, lsum = 0.f;
        const int qcol = j * 16 + i16; int wst = qcol - 8; wst = wst < 0 ? 0 : (wst > 48 ? 48 : wst);
        int bs = j * 16 - 8; bs = bs < 0 ? 0 : (bs > 32 ? 32 : bs);
        const int rel = bs + 4 * g - wst, dcb = bs + 4 * g - qcol + 15;
        v4u stg[4];
#define ATT_ROW0(t) ((t) < nlat ? (size_t)(b * SEQ + (kr_lo + (t)) * GRIDW) : (size_t)(ML + b * CTXL + ((t) - nlat) * 64))
#define ATT_LOAD(t) do { const bf16* src_ = QKV + (ATT_ROW0(t) + key0) * (3 * D) + D + hoff; \
            stg[0] = *(const v4u*)src_; stg[1] = *(const v4u*)(src_ + (size_t)32 * 3 * D); stg[2] = *(const v4u*)(src_ + D); stg[3] = *(const v4u*)(src_ + (size_t)32 * 3 * D + D); } while (0)
#define ATT_WRITE(buf) do { LAS unsigned char* d_ = lds + (buf) * 32768; *(LAS v4u*)(d_ + kw) = stg[0]; *(LAS v4u*)(d_ + kw + 8192) = stg[1]; *(LAS v4u*)(d_ + vw) = stg[2]; *(LAS v4u*)(d_ + vw + 8192) = stg[3]; } while (0)
        ATT_LOAD(0); ATT_WRITE(0);
        __syncthreads();
        for (int t = 0; t < ntiles; ++t) {
            if (t + 1 < ntiles) ATT_LOAD(t + 1);
            const bool tl = t < nlat; const int kr = kr_lo + t;
            const bool active = !tl || (kr >= r0w && kr <= r0w + 7);
            if (active) {
                LAS unsigned char* kb = lds + (t & 1) * 32768;
                const int nst = tl ? 1 : 2;
                for (int st = 0; st < nst; ++st) {
                    const int koff = tl ? bs : 32 * st;
                    f32x4 s0 = (f32x4){0.f, 0.f, 0.f, 0.f}, s1 = (f32x4){0.f, 0.f, 0.f, 0.f};
                    { const int key = koff + i16, sw = key & 15; LAS unsigned char* kp = kb + key * 256;
#pragma unroll
                      for (int sp = 0; sp < 4; ++sp) { const int off = ((4 * sp + g) ^ sw) * 16;
                          const att_s8 k0 = *(LAS att_s8*)(kp + off), k1 = *(LAS att_s8*)(kp + 4096 + off);
                          s0 = __builtin_amdgcn_mfma_f32_16x16x32_bf16(k0, qf[sp], s0, 0, 0, 0); s1 = __builtin_amdgcn_mfma_f32_16x16x32_bf16(k1, qf[sp], s1, 0, 0, 0); } }
                    float tv[8]; float tmax = -1e30f;
                    if (tl) { LAS float* tr = tab + (kr - r_w + 7) * 31;
#pragma unroll
                        for (int e = 0; e < 8; ++e) { const int x = (e >> 2) * 16 + (e & 3); const bool valid = (unsigned)(rel + x) < 16u; int dc = dcb + x; dc = dc < 0 ? 0 : (dc > 30 ? 30 : dc);
                            const float sv = (e < 4 ? s0[e & 3] : s1[e & 3]) * C1 + tr[dc]; tv[e] = valid ? sv : -1e30f; tmax = fmaxf(tmax, tv[e]); } }
                    else {
#pragma unroll
                        for (int e = 0; e < 8; ++e) { tv[e] = (e < 4 ? s0[e & 3] : s1[e & 3]) * C1; tmax = fmaxf(tmax, tv[e]); } }
                    tmax = fmaxf(tmax, __shfl_xor(tmax, 16)); tmax = fmaxf(tmax, __shfl_xor(tmax, 32));
                    const float mn = fmaxf(m, tmax);
                    if (!__all(mn == m)) { const float al = __builtin_amdgcn_exp2f(m - mn); lsum *= al;
#pragma unroll
                        for (int dt = 0; dt < 8; ++dt) o[dt] = o[dt] * al; }
                    m = mn;
                    float p[8];
#pragma unroll
                    for (int e = 0; e < 8; ++e) { p[e] = tv[e] > -1e29f ? __builtin_amdgcn_exp2f(tv[e] - m) : 0.f; lsum += p[e]; }
                    union { att_s8 v; unsigned w[4]; } pf;
                    pf.w[0] = pg8::cvt_pk_bf16(p[0], p[1]); pf.w[1] = pg8::cvt_pk_bf16(p[2], p[3]); pf.w[2] = pg8::cvt_pk_bf16(p[4], p[5]); pf.w[3] = pg8::cvt_pk_bf16(p[6], p[7]);
                    { const int swv = 4 * (g & 1) + (i16 >> 2); LAS unsigned char* vp = kb + 16384 + (koff + 4 * g + (i16 >> 2)) * 256 + (i16 & 3) * 8;
#pragma unroll
                      for (int dt = 0; dt < 8; ++dt) { const int off = (dt ^ swv) * 32;
                          const att_s4 va = __builtin_amdgcn_ds_read_tr16_b64_v4i16((LAS att_s4*)(vp + off)), vb = __builtin_amdgcn_ds_read_tr16_b64_v4i16((LAS att_s4*)(vp + 4096 + off));
                          const att_s8 vf = __builtin_shufflevector(va, vb, 0, 1, 2, 3, 4, 5, 6, 7);
                          o[dt] = __builtin_amdgcn_mfma_f32_16x16x32_bf16(vf, pf.v, o[dt], 0, 0, 0); } }
                }
            }
            if (t + 1 < ntiles) ATT_WRITE((t + 1) & 1);
            __syncthreads();
        }
#undef ATT_ROW0
#undef ATT_LOAD
#undef ATT_WRITE
        lsum += __shfl_xor(lsum, 16); lsum += __shfl_xor(lsum, 32);
        const float inv = 1.0f / lsum;
        bf16* op = O + (size_t)qrow * D + h * HD + 4 * g;
#pragma unroll
        for (int dt = 0; dt < 8; ++dt) { v2u w; w.x = pg8::cvt_pk_bf16(o[dt][0] * inv, o[dt][1] * inv); w.y = pg8::cvt_pk_bf16(o[dt][2] * inv, o[dt][3] * inv); *(v2u*)(op + 16 * dt) = w; }
    }
    __syncthreads();
}

constexpr int NPHASE = 3 + 7 * DEPTH;
__global__ void __launch_bounds__(NWAVES * 64, 2) fwd(Args args) {
    extern __shared__ __attribute__((aligned(16))) unsigned char lds[];
    Frame F;
    F.lds = (LAS unsigned char*)lds;
    F.MISC = (volatile LAS unsigned*)(F.lds + MISC_OFF);
    F.tid = threadIdx.x; F.lane = F.tid & 63; F.wave = __builtin_amdgcn_readfirstlane(F.tid >> 6);
    F.G = gridDim.x; { const int bx = blockIdx.x; F.vcu = (F.G % 8 == 0) ? (bx % 8) * (F.G / 8) + bx / 8 : bx; }
    unsigned char* ws = args.ws;
    F.ctl = (gu32*)(ws + WS_CTL);
    for (int u = F.tid; u < (LDS_BYTES - LDSCTL_OFF) / 4; u += NWAVES * 64) ((LAS unsigned*)(F.lds + LDSCTL_OFF))[u] = 0u;
    __syncthreads();
    const int lo = args.ph_lo, hi = args.ph_hi;
    const bool multi = (hi - lo) > 1;
    XcdBarrier bar; bar.bar = (unsigned*)(F.ctl + CW_BAR); bar.x = 0; bar.st = nullptr;
    if (multi) bar = xcd_barrier_post((unsigned*)(F.ctl + CW_BAR), F.MISC + 8);
#define IN(k) (lo <= (k) && (k) < hi)
#define SEAM(k) do { if (IN((k) + 1)) xcd_barrier(bar); } while (0)

    float* const X = (float*)(ws + WS_X);
    const float* const ADA = (const float*)(ws + WS_ADA);
    bf16* const H = (bf16*)(ws + WS_H);

#ifndef PROBE_ID
#define PROBE_ID 0
#endif
#define NREP(id) ((PROBE_ID) == (id) ? 2 : 1)
    float* const XDUM = (float*)(ws + WS_DUMX); bf16* const HDUM = (bf16*)(ws + WS_DUMH);
    if (IN(0)) { for (int rep = 0; rep < NREP(1); ++rep) { p_ada_partial(F, args); __syncthreads(); p_convert_weights(F, args); p_copy_x(F, args); } SEAM(0); }
    if (IN(1)) { p_ada_reduce(F, args); SEAM(1); }
    if (IN(2)) { p_modulate(F, args, MR, ADA, 0, D); SEAM(2); }

    for (int l = 0; l < DEPTH; ++l) {
        const int pb = 3 + 7 * l;
        const bool use_na = (l & 1) == 0; const int j = l >> 1;
        const int rows = l < 2 ? MR : ML;
        const float* ada_l = ADA + (size_t)l * NCOND * ADAW;
        if (use_na) {
            if (IN(pb + 0)) {
                for (int rep = 0; rep < NREP(2); ++rep) {
                pg8::Gemm g{H, (const bf16*)(ws + WS_WQKV) + (size_t)j * 3 * D * D, MR, 3 * D, D, D, D, 0, 0}; pg8::StaticOrder S; S.init(MR, 3 * D, F.G, (int)blockIdx.x);
                pg8::EpiBf16 E{(bf16*)(ws + WS_QKV), 3 * D};
                pg8::gemm_phase<pg8::EpiBf16, pg8::StaticOrder, true, true>(F.lds + RING_OFF, g, S, E); }
                SEAM(pb + 0);
            }
            if (IN(pb + 1)) { for (int rep = 0; rep < NREP(3); ++rep) p_attention_mfma(F, args, args.na_rpb + (size_t)j * NH * 15 * 31, l == 0); SEAM(pb + 1); }
        } else {
            if (IN(pb + 0)) { for (int rep = 0; rep < NREP(4); ++rep) p_pool(F, args, rows, ada_l); SEAM(pb + 0); }
        }
        if (IN(pb + 2)) {
            for (int rep = 0; rep < NREP(5); ++rep) {
            pg8::Gemm g; pg8::EpiRes E{X, rep == NREP(5) - 1 ? X : XDUM, D, ada_l + 2 * D, ADAW, nullptr, DN_ALPHA};
            if (use_na) g = pg8::Gemm{(const bf16*)(ws + WS_O), (const bf16*)(ws + WS_WO) + (size_t)j * D * D, rows, D, D, D, D, 0, 0};
            else { g = pg8::Gemm{(const bf16*)(ws + WS_O), (const bf16*)(ws + WS_WPOOL) + (size_t)j * D * 512, rows, D, 512, D, 512, 2, 512}; E.colscale = args.pool_scale + (size_t)j * D; }
            pg8::StaticOrder S; S.init(rows, D, F.G, (int)blockIdx.x);
            pg8::gemm_phase<pg8::EpiRes, pg8::StaticOrder, true, true>(F.lds + RING_OFF, g, S, E); }
            SEAM(pb + 2);
        }
        if (IN(pb + 3)) { for (int rep = 0; rep < NREP(6); ++rep) { const bool fin = rep == NREP(6) - 1;
            p_layernorm(F, args, rows, args.ln_mix_g + (size_t)l * D, args.ln_mix_b + (size_t)l * D, fin ? X : XDUM, fin ? H : HDUM, ada_l, 3 * D, 4 * D); } SEAM(pb + 3); }
        if (IN(pb + 4)) {
            for (int rep = 0; rep < NREP(7); ++rep) {
            pg8::Gemm g{H, (const bf16*)(ws + WS_WIN) + (size_t)l * 2 * DFF * D, rows, 2 * DFF, D, D, D, 0, 0}; pg8::StaticOrder S; S.init(rows, 2 * DFF, F.G, (int)blockIdx.x);
            pg8::EpiSwiGLU E{(bf16*)(ws + WS_ACT), DFF};
            pg8::gemm_phase<pg8::EpiSwiGLU, pg8::StaticOrder, true, true>(F.lds + RING_OFF, g, S, E); }
            SEAM(pb + 4);
        }
        if (IN(pb + 5)) {
            for (int rep = 0; rep < NREP(8); ++rep) {
            pg8::Gemm g{(const bf16*)(ws + WS_ACT), (const bf16*)(ws + WS_WOUT) + (size_t)l * D * DFF, rows, D, DFF, DFF, DFF, 0, 0}; pg8::StaticOrder S; S.init(rows, D, F.G, (int)blockIdx.x);
            pg8::EpiRes E{X, rep == NREP(8) - 1 ? X : XDUM, D, ada_l + 5 * D, ADAW, nullptr, DN_ALPHA};
            pg8::gemm_phase<pg8::EpiRes, pg8::StaticOrder, true, true>(F.lds + RING_OFF, g, S, E); }
            SEAM(pb + 5);
        }
        if (IN(pb + 6)) {
            const bool last = (l == DEPTH - 1);
            const int nrows = l < 2 ? MR : ML;
            for (int rep = 0; rep < NREP(6); ++rep) { const bool fin = rep == NREP(6) - 1;
            p_layernorm(F, args, nrows, args.ln_ffn_g + (size_t)l * D, args.ln_ffn_b + (size_t)l * D, fin ? (last ? args.out : X) : XDUM, fin ? H : HDUM, last ? nullptr : ada_l + (size_t)NCOND * ADAW, 0, D); }
            if (!last) SEAM(pb + 6);
        }
    }
#undef IN
#undef SEAM
}

extern "C" void kernel_launch(void* const* d_in, const int* in_sizes, int n_in, void* d_out, int out_size, void* d_ws, size_t ws_size, hipStream_t stream) {
    static int grid = 0;
    if (grid == 0) {
        if (n_in != 17 || out_size != ML * D || ws_size < WS_END) { fprintf(stderr, "kernel_launch: unexpected shapes (n_in %d, out %d, ws %zu); nothing launched\n", n_in, out_size, ws_size); grid = -1; return; }
        int dev = 0, cus = 0, per_cu = 0;
        if (hipGetDevice(&dev) != hipSuccess || hipDeviceGetAttribute(&cus, hipDeviceAttributeMultiprocessorCount, dev) != hipSuccess) { grid = -1; return; }
        if (hipFuncSetAttribute((const void*)fwd, hipFuncAttributeMaxDynamicSharedMemorySize, LDS_BYTES) != hipSuccess) { fprintf(stderr, "kernel_launch: hipFuncSetAttribute failed\n"); grid = -1; return; }
        if (hipOccupancyMaxActiveBlocksPerMultiprocessor(&per_cu, (const void*)fwd, NWAVES * 64, LDS_BYTES) != hipSuccess || per_cu < 1)
            fprintf(stderr, "kernel_launch: note: occupancy query reports %d workgroups per CU\n", per_cu);
        (void)hipGetLastError();
        grid = cus;
    }
    if (grid < 0) return;
    if (hipMemsetAsync((char*)d_ws + WS_CTL, 0, CTL_ZERO_BYTES, stream) != hipSuccess) { fprintf(stderr, "kernel_launch: memset failed\n"); return; }
    Args a{};
    a.x = (const float*)d_in[0]; a.c = (const float*)d_in[1]; a.ctx = (const float*)d_in[2]; a.c_ctx = (const float*)d_in[3]; a.ada_w = (const float*)d_in[4]; a.ada_b = (const float*)d_in[5];
    a.ln_mix_g = (const float*)d_in[6]; a.ln_mix_b = (const float*)d_in[7]; a.ln_ffn_g = (const float*)d_in[8]; a.ln_ffn_b = (const float*)d_in[9];
    a.na_w_qkv = (const float*)d_in[10]; a.na_w_o = (const float*)d_in[11]; a.na_rpb = (const float*)d_in[12]; a.pool_w = (const float*)d_in[13]; a.pool_scale = (const float*)d_in[14];
    a.ffn_w_in = (const float*)d_in[15]; a.ffn_w_out = (const float*)d_in[16];
    a.out = (float*)d_out; a.ws = (unsigned char*)d_ws;
#if MK_ONE_LAUNCH
    a.ph_lo = 0; a.ph_hi = NPHASE;
    hipLaunchKernelGGL(fwd, dim3(grid), dim3(NWAVES * 64), LDS_BYTES, stream, a);
#else
    for (int p = 0; p < NPHASE; ++p) {
        const int l = (p - 3) / 7, s = (p - 3) % 7;
        if (p >= 3 && (l & 1) == 1 && s == 1) continue;
        a.ph_lo = p; a.ph_hi = p + 1;
        hipLaunchKernelGGL(fwd, dim3(grid), dim3(NWAVES * 64), LDS_BYTES, stream, a);
    }
#endif
    const hipError_t le = hipPeekAtLastError();
    if (le != hipSuccess) fprintf(stderr, "kernel_launch: launch failed: %s\n", hipGetErrorName(le));
}
```

```cpp
#include <hip/hip_runtime.h>
#include <cstdio>
#include <cstdint>

#ifndef MK_ONE_LAUNCH
#define MK_ONE_LAUNCH 1
#endif

namespace pg8 {
#define PG8_LAS __attribute__((address_space(3)))
typedef unsigned short bf16_t;
typedef short bf16x8 __attribute__((ext_vector_type(8)));
typedef float f32x4 __attribute__((ext_vector_type(4)));
typedef unsigned u32x4 __attribute__((ext_vector_type(4)));
constexpr int BM = 256, BK = 64, HALF = 128, HTB = HALF * BK * 2  , STAGE_BYTES = 8 * HTB, NXCD = 8, WGM = 8;

__host__ __device__ __forceinline__ int lds_byte(int r, int c) { const int st = (r >> 4) * 2 + (c >> 5), rr = r & 15, cc = c & 31, ob = rr * 64 + cc * 2; return st * 1024 + (ob ^ (((ob >> 9) & 1) << 5)); }
__host__ __device__ __forceinline__ void stage_rc(int b, int& R, int& C) { const int st = b / 1024, sb = b % 1024, swz = sb ^ (((sb >> 9) & 1) << 5); R = (st >> 1) * 16 + swz / 64; C = (st & 1) * 32 + (swz % 64) / 2; }
__host__ __device__ __forceinline__ int perm32(int rho) { const int n = rho >> 4, i = rho & 15; return 8 * (i >> 2) + 4 * n + (i & 3); }

__device__ __forceinline__ int opaque_v(int v) { asm volatile("" : "+v"(v)); return v; }
struct Unit { int pm, pn; };
struct Gemm { const bf16_t* A; const bf16_t* Bt; int M, N, K, lda, ldb, grp_pn, grp_k; };

struct StaticOrder {
    int nM, nN, nwg, G, c;
    __host__ __device__ void init(int M, int N, int G_, int c_) { nM = M / BM; nN = N / BM; nwg = nM * nN; G = G_; c = c_; }
    __host__ __device__ bool next(int i, Unit& u) const {
        const long L = (long)i * G + c; if (L >= nwg) return false;
        int wgid = (int)L; { const int q = nwg / NXCD, r = nwg % NXCD, xcd = wgid % NXCD, off = wgid / NXCD; wgid = (xcd < r ? xcd * (q + 1) : r * (q + 1) + (xcd - r) * q) + off; }
        const int nig = WGM * nN, gid = wgid / nig, fm = gid * WGM, gsz = (nM - fm) < WGM ? (nM - fm) : WGM;
        u.pm = fm + ((wgid % nig) % gsz); u.pn = (wgid % nig) / gsz; return true;
    }
    __device__ __forceinline__ void a_ready(const Unit&) const {}
    __device__ __forceinline__ void done(const Unit&) const {}
};

__device__ __forceinline__ unsigned cvt_pk_bf16(float lo, float hi) { unsigned r; asm volatile("v_cvt_pk_bf16_f32 %0, %1, %2" : "=v"(r) : "v"(lo), "v"(hi)); return r; }

struct EpiBf16 {
    static constexpr bool PERM = true, AFTER_DRAIN = false;
    bf16_t* O; int ldc;
    __device__ __forceinline__ void operator()(const f32x4 (&acc)[2][2][4][2], const Unit& u, int wr, int wc, int fr, int fq) const {
        const int row0 = u.pm * BM + wr * 64 + fr; const int col0 = u.pn * BM + wc * 32 + 8 * fq;
#pragma unroll
        for (int ai = 0; ai < 2; ++ai)
#pragma unroll
            for (int m = 0; m < 4; ++m) { bf16_t* rowp = O + (size_t)(row0 + ai * HALF + m * 16) * ldc + col0;
#pragma unroll
                for (int bj = 0; bj < 2; ++bj) { const f32x4 v0 = acc[ai][bj][m][0], v1 = acc[ai][bj][m][1];
                    u32x4 w; w.x = cvt_pk_bf16(v0[0], v0[1]); w.y = cvt_pk_bf16(v0[2], v0[3]); w.z = cvt_pk_bf16(v1[0], v1[1]); w.w = cvt_pk_bf16(v1[2], v1[3]);
                    *(u32x4*)(rowp + bj * HALF) = w; } }
    }
};
struct EpiSwiGLU {
    static constexpr bool PERM = true, AFTER_DRAIN = false;
    bf16_t* O; int ldc;
    __device__ __forceinline__ float act(float g, float u) const { return g * u * __builtin_amdgcn_rcpf(1.0f + __builtin_amdgcn_exp2f(g * -1.44269504089f)); }
    __device__ __forceinline__ void operator()(const f32x4 (&acc)[2][2][4][2], const Unit& u, int wr, int wc, int fr, int fq) const {
        const int row0 = u.pm * BM + wr * 64 + fr; const int col0 = u.pn * HALF + wc * 32 + 8 * fq;
#pragma unroll
        for (int ai = 0; ai < 2; ++ai)
#pragma unroll
            for (int m = 0; m < 4; ++m) { bf16_t* rowp = O + (size_t)(row0 + ai * HALF + m * 16) * ldc + col0;
                const f32x4 g0 = acc[ai][0][m][0], g1 = acc[ai][0][m][1], u0 = acc[ai][1][m][0], u1 = acc[ai][1][m][1];
                u32x4 w; w.x = cvt_pk_bf16(act(g0[0], u0[0]), act(g0[1], u0[1])); w.y = cvt_pk_bf16(act(g0[2], u0[2]), act(g0[3], u0[3]));
                w.z = cvt_pk_bf16(act(g1[0], u1[0]), act(g1[1], u1[1])); w.w = cvt_pk_bf16(act(g1[2], u1[2]), act(g1[3], u1[3]));
                *(u32x4*)rowp = w; }
    }
};
struct EpiRes {
    static constexpr bool PERM = false, AFTER_DRAIN = false;
    float* X; float* Xo; int ldx; const float* gate; int gate_stride; const float* colscale; float alpha;
    __device__ __forceinline__ void operator()(const f32x4 (&acc)[2][2][4][2], const Unit& u, int wr, int wc, int fr, int fq) const {
        const int row0 = u.pm * BM + wr * 64 + fr, col0 = u.pn * BM + wc * 32 + 4 * fq;
        const int cond = u.pm < 64 ? (u.pm >> 4) : 4;
        const float* gp = gate + (size_t)cond * gate_stride + col0;
        f32x4 gv[2][2];
#pragma unroll
        for (int bj = 0; bj < 2; ++bj)
#pragma unroll
            for (int n = 0; n < 2; ++n) { gv[bj][n] = *(const f32x4*)(gp + bj * HALF + n * 16); if (colscale) gv[bj][n] = gv[bj][n] * *(const f32x4*)(colscale + col0 + bj * HALF + n * 16); }
#pragma unroll
        for (int ai = 0; ai < 2; ++ai) {
            f32x4 xv[4][2][2];
#pragma unroll
            for (int m = 0; m < 4; ++m) { const float* rowp = X + (size_t)(row0 + ai * HALF + m * 16) * ldx + col0;
#pragma unroll
                for (int bj = 0; bj < 2; ++bj)
#pragma unroll
                    for (int n = 0; n < 2; ++n) xv[m][bj][n] = *(const f32x4*)(rowp + bj * HALF + n * 16); }
#pragma unroll
            for (int m = 0; m < 4; ++m) { float* rowo = Xo + (size_t)(row0 + ai * HALF + m * 16) * ldx + col0;
#pragma unroll
                for (int bj = 0; bj < 2; ++bj)
#pragma unroll
                    for (int n = 0; n < 2; ++n) *(f32x4*)(rowo + bj * HALF + n * 16) = xv[m][bj][n] * alpha + gv[bj][n] * acc[ai][bj][m][n]; }
            asm volatile("" ::: "memory"); }
    }
};

template <class Epi, class Sched, bool ALIGN_EPI = false, bool SP2 = false>
__device__ __forceinline__ void gemm_phase(PG8_LAS unsigned char* lds, const Gemm g, const Sched& S, const Epi& E) {
    const int tid = opaque_v(threadIdx.x), wid = __builtin_amdgcn_readfirstlane(tid >> 6), lane = tid & 63, wr = wid >> 2, wc = wid & 3, fr = lane & 15, fq = lane >> 4;
    const int K = g.K, nt = K / BK;
    unsigned voffA[2], voffB[2];
#pragma unroll
    for (int i = 0; i < 2; ++i) { int R, C; stage_rc(tid * 16 + i * 8192, R, C); const int Rb = Epi::PERM ? ((R & ~31) + perm32(R & 31)) : R;
        voffA[i] = (unsigned)(R * g.lda + C) * 2u; voffB[i] = (unsigned)(Rb * g.ldb + C) * 2u; }
    const size_t kstep = (size_t)(BK * 2);
    const size_t hstepA = (size_t)HALF * g.lda * 2, hstepB = (size_t)HALF * g.ldb * 2;
    const size_t tstepA = 2 * hstepA, tstepB = 2 * hstepB;
    const unsigned ldsw = (unsigned)wid * 1024u;
    const int aoff = lds_byte(wr * 64 + fr, fq * 8), boff = lds_byte(wc * 32 + fr, fq * 8);
#define PG8_SA(b, h) (((b) * 2 + (h)) * HTB)
#define PG8_SB(b, h) ((4 + (b) * 2 + (h)) * HTB)
#define PG8_STAGE(bufoff, gbase, voff) do { _Pragma("unroll") for (int _i = 0; _i < 2; ++_i) \
        __builtin_amdgcn_global_load_lds((const unsigned*)((const char*)(gbase) + (voff)[_i]), (PG8_LAS unsigned*)(lds + (bufoff) + ldsw + _i * 8192), 16, 0, 0); } while (0)
#define PG8_LDA(dst, b, h) do { _Pragma("unroll") for (int m = 0; m < 4; ++m) _Pragma("unroll") for (int k = 0; k < 2; ++k) dst[m][k] = *(const PG8_LAS bf16x8*)(lds + PG8_SA(b, h) + aoff + m * 2048 + k * 1024); } while (0)
#define PG8_LDB(dst, b, h) do { _Pragma("unroll") for (int n = 0; n < 2; ++n) _Pragma("unroll") for (int k = 0; k < 2; ++k) dst[n][k] = *(const PG8_LAS bf16x8*)(lds + PG8_SB(b, h) + boff + n * 2048 + k * 1024); } while (0)
#define PG8_MMA(ai, bj, At, Bt) do { __builtin_amdgcn_s_setprio(1); _Pragma("unroll") for (int m = 0; m < 4; ++m) _Pragma("unroll") for (int n = 0; n < 2; ++n) _Pragma("unroll") for (int k = 0; k < 2; ++k) \
        acc[ai][bj][m][n] = __builtin_amdgcn_mfma_f32_16x16x32_bf16(Bt[n][k], At[m][k], acc[ai][bj][m][n], 0, 0, 0); __builtin_amdgcn_s_setprio(0); } while (0)
#define PG8_WAIT_V(n) asm volatile("s_waitcnt vmcnt(" #n ")" ::: "memory")
#define PG8_WAIT_L(n) asm volatile("s_waitcnt lgkmcnt(" #n ")" ::: "memory")
#define PG8_BAR __builtin_amdgcn_s_barrier()
#define PG8_SCHED __builtin_amdgcn_sched_barrier(0)
#define PG8_AOF(u) ((size_t)(u).pm * tstepA + (g.grp_pn ? (size_t)((u).pn / g.grp_pn) * (size_t)g.grp_k * 2 : (size_t)0))
    Unit cur, nxt; int ui = 0;
    if (!S.next(0, cur)) return;
    f32x4 acc[2][2][4][2];
#pragma unroll
    for (int a = 0; a < 2; ++a)
#pragma unroll
        for (int b = 0; b < 2; ++b)
#pragma unroll
            for (int m = 0; m < 4; ++m)
#pragma unroll
                for (int n = 0; n < 2; ++n) acc[a][b][m][n] = (f32x4){0.f, 0.f, 0.f, 0.f};
    bf16x8 At[4][2], B0[2][2], B1[2][2];
    const char* cA = (const char*)g.A + PG8_AOF(cur); const char* cB = (const char*)g.Bt + (size_t)cur.pn * tstepB;
    S.a_ready(cur);
    if constexpr (SP2) {
        PG8_STAGE(PG8_SB(0, 0), cB, voffB); PG8_STAGE(PG8_SB(0, 1), cB + hstepB, voffB); PG8_STAGE(PG8_SA(0, 0), cA, voffA); PG8_STAGE(PG8_SA(0, 1), cA + hstepA, voffA);
        if (wr == 1) PG8_BAR;
        PG8_WAIT_V(2); PG8_BAR;
        PG8_STAGE(PG8_SB(1, 0), cB + kstep, voffB); PG8_STAGE(PG8_SA(1, 0), cA + kstep, voffA); PG8_STAGE(PG8_SB(1, 1), cB + hstepB + kstep, voffB);
        PG8_WAIT_V(6); PG8_BAR;
    } else {
        PG8_STAGE(PG8_SB(0, 0), cB, voffB); PG8_STAGE(PG8_SA(0, 0), cA, voffA); PG8_STAGE(PG8_SB(0, 1), cB + hstepB, voffB); PG8_STAGE(PG8_SA(0, 1), cA + hstepA, voffA);
        if (wr == 1) PG8_BAR;
        PG8_WAIT_V(4); PG8_BAR;
        PG8_STAGE(PG8_SB(1, 0), cB + kstep, voffB); PG8_STAGE(PG8_SA(1, 0), cA + kstep, voffA); PG8_STAGE(PG8_SB(1, 1), cB + hstepB + kstep, voffB);
        PG8_WAIT_V(6); PG8_BAR;
    }
    for (;;) {
        const bool has_next = S.next(ui + 1, nxt);
        const char* nA = has_next ? (const char*)g.A + PG8_AOF(nxt) : cA; const char* nB = has_next ? (const char*)g.Bt + (size_t)nxt.pn * tstepB : cB;
        for (int t = 0; t < nt; t += 2) {
            const bool last = (t == nt - 2);
            const char* a1 = cA + (size_t)(t + 1) * kstep;
            const char* a2 = last ? nA : cA + (size_t)(t + 2) * kstep; const char* b2 = last ? nB : cB + (size_t)(t + 2) * kstep;
            const char* a3 = a2 + kstep; const char* b3 = b2 + kstep;
            if (last && has_next) S.a_ready(nxt);
            if constexpr (SP2) {
            PG8_LDB(B0, 0, 0); PG8_LDB(B1, 0, 1); PG8_SCHED; PG8_LDA(At, 0, 0); PG8_STAGE(PG8_SA(1, 1), a1 + hstepA, voffA);
            PG8_WAIT_V(8); PG8_WAIT_L(0); PG8_BAR; PG8_MMA(0, 0, At, B0); PG8_MMA(0, 1, At, B1); PG8_BAR; PG8_SCHED;
            PG8_LDA(At, 0, 1); PG8_STAGE(PG8_SB(0, 0), b2, voffB); PG8_STAGE(PG8_SB(0, 1), b2 + hstepB, voffB); PG8_STAGE(PG8_SA(0, 0), a2, voffA);
            PG8_WAIT_V(8); PG8_WAIT_L(0); PG8_BAR; PG8_MMA(1, 0, At, B0); PG8_MMA(1, 1, At, B1); PG8_BAR; PG8_SCHED;
            PG8_LDB(B0, 1, 0); PG8_LDB(B1, 1, 1); PG8_SCHED; PG8_LDA(At, 1, 0); PG8_STAGE(PG8_SA(0, 1), a2 + hstepA, voffA);
            PG8_WAIT_V(8); PG8_WAIT_L(0); PG8_BAR; PG8_MMA(0, 0, At, B0); PG8_MMA(0, 1, At, B1); PG8_BAR; PG8_SCHED;
            PG8_LDA(At, 1, 1); PG8_STAGE(PG8_SB(1, 0), b3, voffB); PG8_STAGE(PG8_SB(1, 1), b3 + hstepB, voffB); PG8_STAGE(PG8_SA(1, 0), a3, voffA);
            PG8_WAIT_V(8); PG8_WAIT_L(0); PG8_BAR; PG8_MMA(1, 0, At, B0); PG8_MMA(1, 1, At, B1); PG8_BAR; PG8_SCHED;
            } else {
            PG8_LDB(B0, 0, 0); PG8_SCHED; PG8_LDA(At, 0, 0); PG8_STAGE(PG8_SA(1, 1), a1 + hstepA, voffA);
            PG8_WAIT_L(8); PG8_BAR; PG8_WAIT_L(0); PG8_MMA(0, 0, At, B0); PG8_BAR; PG8_SCHED;
            PG8_LDB(B1, 0, 1); PG8_STAGE(PG8_SB(0, 0), b2, voffB);
            PG8_BAR; PG8_WAIT_L(0); PG8_MMA(0, 1, At, B1); PG8_BAR;
            PG8_LDA(At, 0, 1); PG8_STAGE(PG8_SA(0, 0), a2, voffA);
            PG8_BAR; PG8_WAIT_L(0); PG8_MMA(1, 0, At, B0); PG8_BAR; PG8_SCHED;
            PG8_STAGE(PG8_SB(0, 1), b2 + hstepB, voffB);
            PG8_WAIT_V(6); PG8_BAR; PG8_MMA(1, 1, At, B1); PG8_BAR;
            PG8_LDB(B0, 1, 0); PG8_SCHED; PG8_LDA(At, 1, 0); PG8_STAGE(PG8_SA(0, 1), a2 + hstepA, voffA);
            PG8_WAIT_L(8); PG8_BAR; PG8_WAIT_L(0); PG8_MMA(0, 0, At, B0); PG8_BAR; PG8_SCHED;
            PG8_LDB(B1, 1, 1); PG8_STAGE(PG8_SB(1, 0), b3, voffB);
            PG8_BAR; PG8_WAIT_L(0); PG8_MMA(0, 1, At, B1); PG8_BAR;
            PG8_LDA(At, 1, 1); PG8_STAGE(PG8_SA(1, 0), a3, voffA);
            PG8_BAR; PG8_WAIT_L(0); PG8_MMA(1, 0, At, B0); PG8_BAR; PG8_SCHED;
            PG8_STAGE(PG8_SB(1, 1), b3 + hstepB, voffB);
            PG8_WAIT_V(6); PG8_BAR; PG8_MMA(1, 1, At, B1); PG8_BAR;
            }
        }
        if constexpr (ALIGN_EPI) { if (wr == 0) PG8_BAR; }
        if constexpr (!Epi::AFTER_DRAIN) { E(acc, cur, wr, wc, fr, fq); S.done(cur); }
        if (!has_next) break;
#pragma unroll
        for (int a = 0; a < 2; ++a)
#pragma unroll
            for (int b = 0; b < 2; ++b)
#pragma unroll
                for (int m = 0; m < 4; ++m)
#pragma unroll
                    for (int n = 0; n < 2; ++n) acc[a][b][m][n] = (f32x4){0.f, 0.f, 0.f, 0.f};
        cur = nxt; cA = nA; cB = nB; ++ui;
        if constexpr (ALIGN_EPI) { if (wr == 1) PG8_BAR; }
    }
    PG8_WAIT_V(0);
    if constexpr (!ALIGN_EPI) { if (wr == 0) PG8_BAR; }
    PG8_BAR;
#undef PG8_AOF
#undef PG8_SA
#undef PG8_SB
#undef PG8_STAGE
#undef PG8_LDA
#undef PG8_LDB
#undef PG8_MMA
#undef PG8_WAIT_V
#undef PG8_WAIT_L
#undef PG8_BAR
#undef PG8_SCHED
}
}

constexpr int NWAVES = 8;
constexpr int D = 2048, BATCH = 4, SEQ = 4096, DEPTH = 4, CTXL = 256, GRIDW = 64, NH = 16, HD = 128;
constexpr int DFF = 5632, NADA = 6;
constexpr int ML = BATCH * SEQ;
constexpr int MC = BATCH * CTXL;
constexpr int MR = ML + MC;
constexpr int NCOND = BATCH + 1;
constexpr int ADAW = NADA * D;
constexpr float LN_EPS = 1e-5f;
constexpr float DN_ALPHA = 1.6817928305074290f;
constexpr float ATT_SCALE = 0.08838834764831845f;
constexpr int KSPLIT = 32;

constexpr size_t MiB = 1u << 20;
constexpr size_t WS_CTL = 0, CTL_ZERO_BYTES = 1 * MiB;
constexpr size_t WS_ADA = 1 * MiB;
constexpr size_t WS_PART = 2 * MiB;
constexpr size_t WS_WQKV = 34 * MiB;
constexpr size_t WS_WO = 82 * MiB;
constexpr size_t WS_WPOOL = 98 * MiB;
constexpr size_t WS_WIN = 102 * MiB;
constexpr size_t WS_WOUT = 278 * MiB;
constexpr size_t WS_X = 366 * MiB;
constexpr size_t WS_H = 502 * MiB;
constexpr size_t WS_QKV = 570 * MiB;
constexpr size_t WS_O = 774 * MiB;
constexpr size_t WS_ACT = 842 * MiB;
constexpr size_t WS_DUMX = 1030 * MiB;
constexpr size_t WS_DUMH = 1166 * MiB;
constexpr size_t WS_END = 1234 * MiB;
constexpr int CW_TMO = 0, CW_CODE = 1;
constexpr int CW_BAR = 4096;

constexpr int RING_OFF = 0, RING_BYTES = 131072;
constexpr int LDSCTL_OFF = RING_BYTES, MISC_OFF = LDSCTL_OFF + 320;
constexpr int LDS_BYTES = 147456;

#define GAS __attribute__((address_space(1)))
#define LAS __attribute__((address_space(3)))
typedef unsigned short bf16;
typedef unsigned v4u __attribute__((ext_vector_type(4)));
typedef unsigned v2u __attribute__((ext_vector_type(2)));
typedef float f32x4 __attribute__((ext_vector_type(4)));
typedef GAS unsigned gu32;
#define RLX_AGENT __ATOMIC_RELAXED, __HIP_MEMORY_SCOPE_AGENT
#define LDS_WAIT() asm volatile("s_waitcnt lgkmcnt(0)" ::: "memory")
#define VM_WAIT() asm volatile("s_waitcnt vmcnt(0)" ::: "memory")
__device__ __forceinline__ unsigned f2bf(float f) { unsigned u = __builtin_bit_cast(unsigned, f); return (u + 0x7fffu + ((u >> 16) & 1u)) >> 16; }
__device__ __forceinline__ unsigned pk2(float lo, float hi) { return f2bf(lo) | (f2bf(hi) << 16); }
__device__ __forceinline__ float bf_lo(unsigned w) { return __builtin_bit_cast(float, w << 16); }
__device__ __forceinline__ float bf_hi(unsigned w) { return __builtin_bit_cast(float, w & 0xffff0000u); }

#define XB_TMO      128
#define XB_XCNT(j)  (256  + 64 * (j))
#define XB_XSUB(j)  (1280 + 64 * (j))
#define XB_XGEN(j)  (2304 + 64 * (j))
#define XB_TOP      3328
#define XB_TOPGEN   3392
#define XCD_BAR_WORDS 3456
#define XB_SPIN_CAP (1u << 18)

__device__ __forceinline__ unsigned xb_ld(unsigned* p)              { return __hip_atomic_load(p, __ATOMIC_RELAXED, __HIP_MEMORY_SCOPE_AGENT); }
__device__ __forceinline__ unsigned xb_add(unsigned* p, unsigned v) { return __hip_atomic_fetch_add(p, v, __ATOMIC_RELAXED, __HIP_MEMORY_SCOPE_AGENT); }
__device__ __forceinline__ unsigned xb_xcc_id() { return (unsigned)__builtin_amdgcn_s_getreg((3 << 11) | 20) & 0xFu; }
#define XB_SPIN(cond, bar) do { unsigned _sp = 0; while (cond) { __builtin_amdgcn_s_sleep(1); \
    if ((++_sp & 255u) == 0u) { if (xb_ld(&(bar)[XB_TMO])) break; if (_sp > XB_SPIN_CAP) { atomicAdd(&(bar)[XB_TMO], 1u); break; } } } } while (0)

struct XcdBarrier { unsigned* bar; unsigned x; volatile LAS unsigned* st; };

__device__ __forceinline__ XcdBarrier xcd_barrier_post(unsigned* bar, volatile LAS unsigned* st) {
    XcdBarrier b; b.bar = bar; b.x = xb_xcc_id(); b.st = st;
    if (threadIdx.x == 0) (void)xb_add(&bar[XB_XCNT(b.x)], 1u);
    return b;
}
__device__ __forceinline__ void xcd_barrier_complete(unsigned* bar, unsigned x, unsigned& nloc, unsigned& nx) {
    const unsigned G = gridDim.x * gridDim.y * gridDim.z;
    unsigned sum, cnt, mine, sp = 0u;
    for (;;) {
        sum = 0u; cnt = 0u; mine = 0u;
#pragma unroll
        for (unsigned j = 0; j < 16; ++j) { const unsigned c = xb_ld(&bar[XB_XCNT(j)]); sum += c; cnt += (c > 0u) ? 1u : 0u; mine = (j == x) ? c : mine; }
        if (sum == G) break;
        __builtin_amdgcn_s_sleep(1);
        if ((++sp & 255u) == 0u) { if (xb_ld(&bar[XB_TMO])) break; if (sp > XB_SPIN_CAP) { atomicAdd(&bar[XB_TMO], 1u); break; } }
    }
    nloc = mine > 0u ? mine : 1u; nx = cnt > 0u ? cnt : 1u;
}
__device__ __forceinline__ void xcd_barrier(const XcdBarrier& b) {
    asm volatile("s_waitcnt vmcnt(0)" ::: "memory");
    __syncthreads();
    if (threadIdx.x == 0) {
        unsigned* bar = b.bar;
        __builtin_amdgcn_s_waitcnt(0);
        unsigned nloc = b.st[0], nx = b.st[1];
        if (nloc == 0u) { xcd_barrier_complete(bar, b.x, nloc, nx); b.st[0] = nloc; b.st[1] = nx; }
        const unsigned old = xb_add(&bar[XB_XSUB(b.x)], 1u);
        const unsigned gen = old / nloc;
        if (old + 1u == (gen + 1u) * nloc) {
            __builtin_amdgcn_fence(__ATOMIC_RELEASE, "agent");
            asm volatile("s_waitcnt vmcnt(0)" ::: "memory");
            const unsigned og = xb_add(&bar[XB_TOP], 1u);
            const unsigned tg = og / nx;
            if (og + 1u == (tg + 1u) * nx) xb_add(&bar[XB_TOPGEN], 1u);
            else XB_SPIN(xb_ld(&bar[XB_TOPGEN]) == tg, bar);
            __builtin_amdgcn_fence(__ATOMIC_ACQUIRE, "agent");
            xb_add(&bar[XB_XGEN(b.x)], 1u);
            asm volatile("s_waitcnt vmcnt(0)" ::: "memory");
        } else {
            XB_SPIN(xb_ld(&bar[XB_XGEN(b.x)]) == gen, bar);
            __builtin_amdgcn_fence(__ATOMIC_ACQUIRE, "agent");
            asm volatile("s_waitcnt vmcnt(0)" ::: "memory");
        }
    }
    __syncthreads();
}

struct Args {
    const float *x, *c, *ctx, *c_ctx, *ada_w, *ada_b, *ln_mix_g, *ln_mix_b, *ln_ffn_g, *ln_ffn_b, *na_w_qkv, *na_w_o, *na_rpb, *pool_w, *pool_scale, *ffn_w_in, *ffn_w_out;
    float* out; unsigned char* ws; int ph_lo, ph_hi;
};
struct Frame {
    LAS unsigned char* lds;
    volatile LAS unsigned* MISC;
    gu32* ctl;
    int tid, lane, wave;
    int vcu, G;
};

__device__ __forceinline__ float wave_sum(float v) {
#pragma unroll
    for (int o = 1; o < 64; o <<= 1) v += __shfl_xor(v, o);
    return v;
}
__device__ __forceinline__ float silu_f(float v) { return v / (1.0f + __expf(-v)); }

__device__ __forceinline__ void transpose_item(const float* W, int N, bf16* WT, int ldt, int drow0, LAS float* scr, int k0, int n0, int lane) {
#pragma unroll 8
    for (int i = 0; i < 32; ++i) { const int kk = 2 * i + (lane >> 5); scr[kk * 33 + (lane & 31)] = W[(size_t)(k0 + kk) * N + n0 + (lane & 31)]; }
    LDS_WAIT(); asm volatile("" ::: "memory");
    const int c = lane & 7;
#pragma unroll
    for (int j = 0; j < 4; ++j) { const int n = (lane >> 3) + 8 * j; const LAS float* s = scr + (8 * c) * 33 + n;
        v4u o; o.x = pk2(s[0 * 33], s[1 * 33]); o.y = pk2(s[2 * 33], s[3 * 33]); o.z = pk2(s[4 * 33], s[5 * 33]); o.w = pk2(s[6 * 33], s[7 * 33]);
        *(GAS v4u*)(WT + (size_t)(drow0 + n) * ldt + k0 + 8 * c) = o; }
    LDS_WAIT(); asm volatile("" ::: "memory");
}

__device__ __forceinline__ void p_convert_weights(Frame F, const Args& a) {
    F.tid = pg8::opaque_v(F.tid); F.lane = F.tid & 63;
    LAS float* scr = (LAS float*)(F.lds + RING_OFF + F.wave * 16384);
    const int gw = F.vcu * NWAVES + F.wave, NGW = F.G * NWAVES;
    unsigned char* ws = a.ws;
    constexpr int I_QKV = (D / 64) * (3 * D / 32), I_O = (D / 64) * (D / 32), I_POOL = (512 / 64) * (512 / 32), I_IN = (D / 64) * (2 * DFF / 32), I_OUT = (DFF / 64) * (D / 32);
    constexpr int T_QKV = 2 * I_QKV, T_O = 2 * I_O, T_POOL = 8 * I_POOL, T_IN = 4 * I_IN, T_OUT = 4 * I_OUT;
    constexpr int NITEMS = T_QKV + T_O + T_POOL + T_IN + T_OUT;
    for (int it = gw; it < NITEMS; it += NGW) {
        int r = it;
        if (r < T_QKV) { const int j = r / I_QKV, q = r % I_QKV, nblk = 3 * D / 32, kb = q / nblk, nb = q % nblk;
            transpose_item(a.na_w_qkv + (size_t)j * D * 3 * D, 3 * D, (bf16*)(ws + WS_WQKV) + (size_t)j * 3 * D * D, D, 32 * nb, scr, 64 * kb, 32 * nb, F.lane); continue; } r -= T_QKV;
        if (r < T_O) { const int j = r / I_O, q = r % I_O, nblk = D / 32, kb = q / nblk, nb = q % nblk;
            transpose_item(a.na_w_o + (size_t)j * D * D, D, (bf16*)(ws + WS_WO) + (size_t)j * D * D, D, 32 * nb, scr, 64 * kb, 32 * nb, F.lane); continue; } r -= T_O;
        if (r < T_POOL) { const int jg = r / I_POOL, q = r % I_POOL, nblk = 512 / 32, kb = q / nblk, nb = q % nblk;
            transpose_item(a.pool_w + (size_t)jg * 512 * 512, 512, (bf16*)(ws + WS_WPOOL) + (size_t)(jg >> 2) * D * 512, 512, (jg & 3) * 512 + 32 * nb, scr, 64 * kb, 32 * nb, F.lane); continue; } r -= T_POOL;
        if (r < T_IN) { const int l = r / I_IN, q = r % I_IN, nblk = 2 * DFF / 32, kb = q / nblk, nb = q % nblk; const int n0 = 32 * nb, bj = n0 / DFF, jj = n0 % DFF;
            transpose_item(a.ffn_w_in + (size_t)l * D * 2 * DFF, 2 * DFF, (bf16*)(ws + WS_WIN) + (size_t)l * 2 * DFF * D, D, 256 * (jj / 128) + 128 * bj + (jj % 128), scr, 64 * kb, n0, F.lane); continue; } r -= T_IN;
        { const int l = r / I_OUT, q = r % I_OUT, nblk = D / 32, kb = q / nblk, nb = q % nblk;
            transpose_item(a.ffn_w_out + (size_t)l * DFF * D, D, (bf16*)(ws + WS_WOUT) + (size_t)l * D * DFF, DFF, 32 * nb, scr, 64 * kb, 32 * nb, F.lane); }
    }
}
__device__ __forceinline__ void p_copy_x(Frame F, const Args& a) {
    F.tid = pg8::opaque_v(F.tid); F.lane = F.tid & 63;
    float* X = (float*)(a.ws + WS_X);
    const size_t n4l = (size_t)ML * D / 4, n4c = (size_t)MC * D / 4, stride = (size_t)F.G * 512;
    const f32x4* s0 = (const f32x4*)a.x; const f32x4* s1 = (const f32x4*)a.ctx; f32x4* d = (f32x4*)X;
    for (size_t i = (size_t)F.vcu * 512 + F.tid; i < n4l + n4c; i += stride) d[i] = i < n4l ? s0[i] : s1[i - n4l];
}
__device__ __forceinline__ void p_ada_partial(Frame F, const Args& a) {
    F.tid = pg8::opaque_v(F.tid); F.lane = F.tid & 63;
    LAS float* sc = (LAS float*)(F.lds + RING_OFF);
    float* PART = (float*)(a.ws + WS_PART);
    constexpr int NCC = ADAW / 2048, NITEMS = DEPTH * NCC * KSPLIT;
    for (int it = F.vcu; it < NITEMS; it += F.G) {
        const int kc = it % KSPLIT, cc = (it / KSPLIT) % NCC, l = it / (KSPLIT * NCC);
        __syncthreads();
        if (F.tid < NCOND * 64) { const int i = F.tid >> 6, k = kc * 64 + (F.tid & 63); const float v = i < BATCH ? a.c[i * D + k] : a.c_ctx[k]; sc[F.tid] = silu_f(v); }
        __syncthreads();
        const float* wp = a.ada_w + ((size_t)l * D + kc * 64) * ADAW + cc * 2048 + 4 * F.tid;
        f32x4 acc[NCOND];
#pragma unroll
        for (int i = 0; i < NCOND; ++i) acc[i] = (f32x4){0.f, 0.f, 0.f, 0.f};
#pragma unroll 8
        for (int k = 0; k < 64; ++k) { const f32x4 w = *(const f32x4*)(wp + (size_t)k * ADAW);
#pragma unroll
            for (int i = 0; i < NCOND; ++i) acc[i] += w * sc[i * 64 + k]; }
#pragma unroll
        for (int i = 0; i < NCOND; ++i) *(f32x4*)(PART + (((size_t)kc * DEPTH + l) * NCOND + i) * ADAW + cc * 2048 + 4 * F.tid) = acc[i];
    }
}
__device__ __forceinline__ void p_ada_reduce(Frame F, const Args& a) {
    F.tid = pg8::opaque_v(F.tid); F.lane = F.tid & 63;
    const float* PART = (const float*)(a.ws + WS_PART); float* ADA = (float*)(a.ws + WS_ADA);
    constexpr int N4 = DEPTH * NCOND * ADAW / 4;
    for (int i = F.vcu * 512 + F.tid; i < N4; i += F.G * 512) {
        const int col4 = i % (ADAW / 4), l = i / (NCOND * ADAW / 4);
        f32x4 s = *(const f32x4*)(a.ada_b + (size_t)l * ADAW + 4 * col4);
        for (int kc = 0; kc < KSPLIT; ++kc) s += *(const f32x4*)(PART + (size_t)kc * DEPTH * NCOND * ADAW + 4 * (size_t)i);
        *(f32x4*)(ADA + 4 * (size_t)i) = s;
    }
}
__device__ __forceinline__ void p_modulate(Frame F, const Args& a, int nrows, const float* ada_l, int sh_off, int sc_off) {
    F.tid = pg8::opaque_v(F.tid); F.lane = F.tid & 63;
    const float* X = (const float*)(a.ws + WS_X); bf16* H = (bf16*)(a.ws + WS_H);
    const int gw = F.vcu * NWAVES + F.wave, NGW = F.G * NWAVES;
    for (int r = gw; r < nrows; r += NGW) {
        const int cond = r < ML ? r / SEQ : BATCH; const float* ap = ada_l + (size_t)cond * ADAW;
#pragma unroll
        for (int j = 0; j < 8; ++j) { const int col = 4 * F.lane + 256 * j; const f32x4 v = *(const f32x4*)(X + (size_t)r * D + col), sh = *(const f32x4*)(ap + sh_off + col), sc = *(const f32x4*)(ap + sc_off + col);
            const f32x4 h = v * (sc + 1.0f) + sh; v2u o; o.x = pk2(h[0], h[1]); o.y = pk2(h[2], h[3]); *(v2u*)(H + (size_t)r * D + col) = o; }
    }
}
__device__ __forceinline__ void p_layernorm(Frame F, const Args& a, int nrows, const float* g, const float* b, float* outp, bf16* H, const float* ada_n, int sh_off, int sc_off) {
    F.tid = pg8::opaque_v(F.tid); F.lane = F.tid & 63;
    const float* X = (const float*)(a.ws + WS_X);
    const int gw = F.vcu * NWAVES + F.wave, NGW = F.G * NWAVES;
    const int per = (nrows + NGW - 1) / NGW; const int r_lo = gw * per; int r_hi = r_lo + per; r_hi = r_hi > nrows ? nrows : r_hi;
    if (r_lo >= r_hi) return;
    f32x4 gv[8], bv[8], hg[8], hb[8];
#pragma unroll
    for (int j = 0; j < 8; ++j) { const int col = 4 * F.lane + 256 * j; gv[j] = *(const f32x4*)(g + col); bv[j] = *(const f32x4*)(b + col); hg[j] = gv[j]; hb[j] = bv[j]; }
    int cond_cur = -1;
    f32x4 nx[8];
#pragma unroll
    for (int j = 0; j < 8; ++j) nx[j] = *(const f32x4*)(X + (size_t)r_lo * D + 4 * F.lane + 256 * j);
    for (int r = r_lo; r < r_hi; ++r) {
        f32x4 v[8]; float s = 0.f;
#pragma unroll
        for (int j = 0; j < 8; ++j) { v[j] = nx[j]; s += (v[j][0] + v[j][1]) + (v[j][2] + v[j][3]); }
        if (r + 1 < r_hi) {
#pragma unroll
            for (int j = 0; j < 8; ++j) nx[j] = *(const f32x4*)(X + (size_t)(r + 1) * D + 4 * F.lane + 256 * j); }
        const int cond = r < ML ? r / SEQ : BATCH;
        if (ada_n && cond != cond_cur) { cond_cur = cond; const float* ap = ada_n + (size_t)cond * ADAW;
#pragma unroll
            for (int j = 0; j < 8; ++j) { const int col = 4 * F.lane + 256 * j; const f32x4 sc1 = *(const f32x4*)(ap + sc_off + col) + 1.0f, sh = *(const f32x4*)(ap + sh_off + col); hg[j] = gv[j] * sc1; hb[j] = bv[j] * sc1 + sh; } }
        const float mean = wave_sum(s) * (1.f / D); float s2 = 0.f;
#pragma unroll
        for (int j = 0; j < 8; ++j) { v[j] = v[j] - mean; s2 += (v[j][0] * v[j][0] + v[j][1] * v[j][1]) + (v[j][2] * v[j][2] + v[j][3] * v[j][3]); }
        const float rstd = 1.f / sqrtf(wave_sum(s2) * (1.f / D) + LN_EPS);
#pragma unroll
        for (int j = 0; j < 8; ++j) { const int col = 4 * F.lane + 256 * j; const f32x4 yh = v[j] * rstd;
            *(f32x4*)(outp + (size_t)r * D + col) = yh * gv[j] + bv[j];
            if (ada_n) { const f32x4 h = yh * hg[j] + hb[j]; v2u o; o.x = pk2(h[0], h[1]); o.y = pk2(h[2], h[3]); *(v2u*)(H + (size_t)r * D + col) = o; } }
    }
}
__device__ __forceinline__ void p_pool(Frame F, const Args& a, int nrows, const float* ada_l) {
    F.tid = pg8::opaque_v(F.tid); F.lane = F.tid & 63;
    const float* X = (const float*)(a.ws + WS_X); bf16* P = (bf16*)(a.ws + WS_O);
    const int gw = F.vcu * NWAVES + F.wave, NGW = F.G * NWAVES;
    constexpr int RUN = 32;
    const int nitems = (nrows / RUN) * 8;
    for (int it = gw; it < nitems; it += NGW) {
        const int cs = it & 7, r0 = (it >> 3) * RUN;
        int base, t0, L, cond;
        if (r0 < ML) { cond = r0 / SEQ; base = cond * SEQ; t0 = r0 - base; L = SEQ; } else { const int q = r0 - ML; cond = BATCH; base = ML + (q / CTXL) * CTXL; t0 = q % CTXL; L = CTXL; }
        const int col = cs * 256 + 4 * F.lane; const int w = 2 << (cs >> 1), hw = w >> 1;
        const f32x4 sc1 = *(const f32x4*)(ada_l + (size_t)cond * ADAW + D + col) + 1.0f;
        const float* xb = X + (size_t)base * D + col;
        int lo = t0 - hw, hi = lo + w; lo = lo < 0 ? 0 : lo; hi = hi > L ? L : hi;
        f32x4 s = (f32x4){0.f, 0.f, 0.f, 0.f};
        for (int tt = lo; tt < hi; ++tt) s += *(const f32x4*)(xb + (size_t)tt * D);
#pragma unroll 4
        for (int i = 0; i < RUN; ++i) { const int t = t0 + i;
            int l2 = t - hw, h2 = l2 + w; const int lo_c = l2 < 0 ? 0 : l2, hi_c = h2 > L ? L : h2;
            const f32x4 xv = *(const f32x4*)(xb + (size_t)t * D);
            const f32x4 p = (s * (1.0f / (float)(hi_c - lo_c)) - xv) * sc1;
            v2u o; o.x = pk2(p[0], p[1]); o.y = pk2(p[2], p[3]); *(v2u*)(P + (size_t)(base + t) * D + col) = o;
            if (h2 < L) s += *(const f32x4*)(xb + (size_t)h2 * D);
            if (l2 >= 0) s -= *(const f32x4*)(xb + (size_t)l2 * D);
        }
    }
}
#define ATT_CHUNK(KEYPTR_EXPR, VALID_EXPR, BIAS_EXPR) do { \
    float s_[4]; v4u kk_[4][4]; \
    _Pragma("unroll") for (int e = 0; e < 4; ++e) { const bf16* kp_ = (KEYPTR_EXPR); _Pragma("unroll") for (int i = 0; i < 4; ++i) kk_[e][i] = *(const v4u*)(kp_ + 8 * i); } \
    _Pragma("unroll") for (int e = 0; e < 4; ++e) { float d_ = 0.f; \
        _Pragma("unroll") for (int i = 0; i < 4; ++i) { const v4u w_ = kk_[e][i]; \
            d_ += qf[8 * i + 0] * bf_lo(w_.x) + qf[8 * i + 1] * bf_hi(w_.x) + qf[8 * i + 2] * bf_lo(w_.y) + qf[8 * i + 3] * bf_hi(w_.y) \
                + qf[8 * i + 4] * bf_lo(w_.z) + qf[8 * i + 5] * bf_hi(w_.z) + qf[8 * i + 6] * bf_lo(w_.w) + qf[8 * i + 7] * bf_hi(w_.w); } \
        d_ += __shfl_xor(d_, 1); d_ += __shfl_xor(d_, 2); \
        s_[e] = (VALID_EXPR) ? d_ + (BIAS_EXPR) : -1e30f; } \
    const float cm_ = fmaxf(fmaxf(s_[0], s_[1]), fmaxf(s_[2], s_[3])); const float mn_ = fmaxf(m, cm_); const float rs_ = __expf(m - mn_); m = mn_; l *= rs_; \
    _Pragma("unroll") for (int i = 0; i < 32; ++i) acc[i] *= rs_; \
    _Pragma("unroll") for (int e = 0; e < 4; ++e) { const float p_ = (s_[e] > -1e29f) ? __expf(s_[e] - m) : 0.f; l += p_; const bf16* vp_ = (KEYPTR_EXPR) + D; \
        _Pragma("unroll") for (int i = 0; i < 4; ++i) { const v4u w_ = *(const v4u*)(vp_ + 8 * i); \
            acc[8 * i + 0] += p_ * bf_lo(w_.x); acc[8 * i + 1] += p_ * bf_hi(w_.x); acc[8 * i + 2] += p_ * bf_lo(w_.y); acc[8 * i + 3] += p_ * bf_hi(w_.y); \
            acc[8 * i + 4] += p_ * bf_lo(w_.z); acc[8 * i + 5] += p_ * bf_hi(w_.z); acc[8 * i + 6] += p_ * bf_lo(w_.w); acc[8 * i + 7] += p_ * bf_hi(w_.w); } } \
} while (0)

__device__ __forceinline__ void p_attention_valu(Frame F, const Args& a, const float* rpb, bool ctx_queries) {
    F.tid = pg8::opaque_v(F.tid); F.lane = F.tid & 63;
    const bf16* QKV = (const bf16*)(a.ws + WS_QKV); bf16* O = (bf16*)(a.ws + WS_O);
    const int gw = F.vcu * NWAVES + F.wave, NGW = F.G * NWAVES;
    const int q = F.lane >> 2, ds = F.lane & 3;
    constexpr int N_LAT = BATCH * 64 * 4 * NH, N_CTX = BATCH * (CTXL / 16) * NH;
    const int ntot = N_LAT + (ctx_queries ? N_CTX : 0);
    for (int u = gw; u < ntot; u += NGW) {
        const bool lat = u < N_LAT; int b, h, qrow, r = 0, j = 0, r0 = 0;
        if (lat) { h = u & 15; int t = u >> 4; j = t & 3; t >>= 2; r = t & 63; b = t >> 6; qrow = b * SEQ + r * GRIDW + j * 16 + q; r0 = r - 4; r0 = r0 < 0 ? 0 : (r0 > 56 ? 56 : r0); }
        else { int t = u - N_LAT; h = t & 15; t >>= 4; const int qb = t & 15; b = t >> 4; qrow = ML + b * CTXL + qb * 16 + q; }
        float qf[32], acc[32];
        { const bf16* qp = QKV + (size_t)qrow * (3 * D) + h * HD + ds * 32;
#pragma unroll
          for (int i = 0; i < 4; ++i) { const v4u w = *(const v4u*)(qp + 8 * i);
              qf[8 * i + 0] = bf_lo(w.x) * ATT_SCALE; qf[8 * i + 1] = bf_hi(w.x) * ATT_SCALE; qf[8 * i + 2] = bf_lo(w.y) * ATT_SCALE; qf[8 * i + 3] = bf_hi(w.y) * ATT_SCALE;
              qf[8 * i + 4] = bf_lo(w.z) * ATT_SCALE; qf[8 * i + 5] = bf_hi(w.z) * ATT_SCALE; qf[8 * i + 6] = bf_lo(w.w) * ATT_SCALE; qf[8 * i + 7] = bf_hi(w.w) * ATT_SCALE; } }
#pragma unroll
        for (int i = 0; i < 32; ++i) acc[i] = 0.f;
        float m = -1e30f, l = 0.f;
        const bf16* kc_base = QKV + (size_t)(ML + b * CTXL) * (3 * D) + D + h * HD + ds * 32;
        for (int k0 = 0; k0 < CTXL; k0 += 4) { ATT_CHUNK(kc_base + (size_t)(k0 + e) * (3 * D), true, 0.f); }
        if (lat) {
            const int qcol = j * 16 + q; int wst = qcol - 8; wst = wst < 0 ? 0 : (wst > 48 ? 48 : wst);
            int bs = j * 16 - 8; bs = bs < 0 ? 0 : (bs > 32 ? 32 : bs);
            const float* rp = rpb + (size_t)h * 15 * 31;
            for (int i = 0; i < 8; ++i) {
                const bf16* krow = QKV + (size_t)(b * SEQ + (r0 + i) * GRIDW + bs) * (3 * D) + D + h * HD + ds * 32;
                const float* rpi = rp + (r0 + i - r + 7) * 31;
                for (int c4 = 0; c4 < 32; c4 += 4) {
#define ATT_KC (bs + c4 + e)
#define ATT_DC (ATT_KC - qcol + 15)
                    ATT_CHUNK(krow + (size_t)(c4 + e) * (3 * D), (ATT_KC >= wst && ATT_KC < wst + 16), rpi[ATT_DC < 0 ? 0 : (ATT_DC > 30 ? 30 : ATT_DC)]);
#undef ATT_KC
#undef ATT_DC
                }
            }
        }
        const float inv = 1.0f / l;
        bf16* op = O + (size_t)qrow * D + h * HD + ds * 32;
#pragma unroll
        for (int i = 0; i < 4; ++i) { v4u w; w.x = pk2(acc[8 * i + 0] * inv, acc[8 * i + 1] * inv); w.y = pk2(acc[8 * i + 2] * inv, acc[8 * i + 3] * inv);
            w.z = pk2(acc[8 * i + 4] * inv, acc[8 * i + 5] * inv); w.w = pk2(acc[8 * i + 6] * inv, acc[8 * i + 7] * inv); *(v4u*)(op + 8 * i) = w; }
    }
}

typedef short att_s4 __attribute__((ext_vector_type(4)));
typedef short att_s8 __attribute__((ext_vector_type(8)));
constexpr int ATT_TAB_OFF = 65536;
__device__ __forceinline__ void p_attention_mfma(Frame F, const Args& a, const float* rpb, bool ctx_queries) {
    F.tid = pg8::opaque_v(F.tid); F.lane = F.tid & 63;
    const bf16* QKV = (const bf16*)(a.ws + WS_QKV); bf16* O = (bf16*)(a.ws + WS_O);
    LAS unsigned char* lds = F.lds + RING_OFF;
    LAS float* tab = (LAS float*)(lds + ATT_TAB_OFF);
    const int tid = F.tid, lane = F.lane, wave = F.wave, i16 = lane & 15, g = lane >> 4;
    constexpr int NU_LAT = BATCH * NH * 32, NU_CTX = BATCH * NH * 2;
    constexpr float L2E = 1.44269504089f, C1 = ATT_SCALE * L2E;
    const int nu = NU_LAT + (ctx_queries ? NU_CTX : 0);
    const int ch = tid & 15, key0 = tid >> 4;
    const int kw = key0 * 256 + ((ch ^ (key0 & 15)) * 16), vw = 16384 + key0 * 256 + (((ch >> 1) ^ (key0 & 7)) * 32) + (ch & 1) * 16;
    for (int u = F.vcu; u < nu; u += F.G) {
        const bool lat = u < NU_LAT;
        int b, h, qrow, r_w = 0, j = 0, kr_lo = 0, nlat = 0;
        if (lat) { const int rp = u & 31; h = (u >> 5) & 15; b = u >> 9; r_w = 2 * rp + (wave >> 2); j = wave & 3; qrow = b * SEQ + r_w * GRIDW + j * 16 + i16;
            int lo = 2 * rp - 4; lo = lo < 0 ? 0 : (lo > 56 ? 56 : lo); int hi = 2 * rp - 3; hi = hi < 0 ? 0 : (hi > 56 ? 56 : hi); kr_lo = lo; nlat = hi + 8 - lo; }
        else { const int t = u - NU_LAT; h = (t >> 1) & 15; b = t >> 5; qrow = ML + b * CTXL + (t & 1) * 128 + wave * 16 + i16; }
        int r0w = r_w - 4; r0w = r0w < 0 ? 0 : (r0w > 56 ? 56 : r0w);
        const int ntiles = nlat + CTXL / 64;
        const size_t hoff = (size_t)h * HD + ch * 8;
        __syncthreads();
        if (lat && tid < 15 * 31) tab[tid] = rpb[(size_t)h * 15 * 31 + tid] * L2E;
        att_s8 qf[4];
        { const bf16* qp = QKV + (size_t)qrow * (3 * D) + h * HD + 8 * g;
#pragma unroll
          for (int st = 0; st < 4; ++st) qf[st] = *(const att_s8*)(qp + 32 * st); }
        f32x4 o[8];
#pragma unroll
        for (int dt = 0; dt < 8; ++dt) o[dt] = (f32x4){0.f, 0.f, 0.f, 0.f};
        float m = -1e30f, lsum = 0.f;
        const int qcol = j * 16 + i16; int wst = qcol - 8; wst = wst < 0 ? 0 : (wst > 48 ? 48 : wst);
        int bs = j * 16 - 8; bs = bs < 0 ? 0 : (bs > 32 ? 32 : bs);
        const int rel = bs + 4 * g - wst, dcb = bs + 4 * g - qcol + 15;
        v4u stg[4];
#define ATT_ROW0(t) ((t) < nlat ? (size_t)(b * SEQ + (kr_lo + (t)) * GRIDW) : (size_t)(ML + b * CTXL + ((t) - nlat) * 64))
#define ATT_LOAD(t) do { const bf16* src_ = QKV + (ATT_ROW0(t) + key0) * (3 * D) + D + hoff; \
            stg[0] = *(const v4u*)src_; stg[1] = *(const v4u*)(src_ + (size_t)32 * 3 * D); stg[2] = *(const v4u*)(src_ + D); stg[3] = *(const v4u*)(src_ + (size_t)32 * 3 * D + D); } while (0)
#define ATT_WRITE(buf) do { LAS unsigned char* d_ = lds + (buf) * 32768; *(LAS v4u*)(d_ + kw) = stg[0]; *(LAS v4u*)(d_ + kw + 8192) = stg[1]; *(LAS v4u*)(d_ + vw) = stg[2]; *(LAS v4u*)(d_ + vw + 8192) = stg[3]; } while (0)
        ATT_LOAD(0); ATT_WRITE(0);
        __syncthreads();
        for (int t = 0; t < ntiles; ++t) {
            if (t + 1 < ntiles) ATT_LOAD(t + 1);
            const bool tl = t < nlat; const int kr = kr_lo + t;
            const bool active = !tl || (kr >= r0w && kr <= r0w + 7);
            if (active) {
                LAS unsigned char* kb = lds + (t & 1) * 32768;
                const int nst = tl ? 1 : 2;
                for (int st = 0; st < nst; ++st) {
                    const int koff = tl ? bs : 32 * st;
                    f32x4 s0 = (f32x4){0.f, 0.f, 0.f, 0.f}, s1 = (f32x4){0.f, 0.f, 0.f, 0.f};
                    { const int key = koff + i16, sw = key & 15; LAS unsigned char* kp = kb + key * 256;
#pragma unroll
                      for (int sp = 0; sp < 4; ++sp) { const int off = ((4 * sp + g) ^ sw) * 16;
                          const att_s8 k0 = *(LAS att_s8*)(kp + off), k1 = *(LAS att_s8*)(kp + 4096 + off);
                          s0 = __builtin_amdgcn_mfma_f32_16x16x32_bf16(k0, qf[sp], s0, 0, 0, 0); s1 = __builtin_amdgcn_mfma_f32_16x16x32_bf16(k1, qf[sp], s1, 0, 0, 0); } }
                    float tv[8]; float tmax = -1e30f;
                    if (tl) { LAS float* tr = tab + (kr - r_w + 7) * 31;
#pragma unroll
                        for (int e = 0; e < 8; ++e) { const int x = (e >> 2) * 16 + (e & 3); const bool valid = (unsigned)(rel + x) < 16u; int dc = dcb + x; dc = dc < 0 ? 0 : (dc > 30 ? 30 : dc);
                            const float sv = (e < 4 ? s0[e & 3] : s1[e & 3]) * C1 + tr[dc]; tv[e] = valid ? sv : -1e30f; tmax = fmaxf(tmax, tv[e]); } }
                    else {
#pragma unroll
                        for (int e = 0; e < 8; ++e) { tv[e] = (e < 4 ? s0[e & 3] : s1[e & 3]) * C1; tmax = fmaxf(tmax, tv[e]); } }
                    tmax = fmaxf(tmax, __shfl_xor(tmax, 16)); tmax = fmaxf(tmax, __shfl_xor(tmax, 32));
                    const float mn = fmaxf(m, tmax);
                    if (!__all(mn == m)) { const float al = __builtin_amdgcn_exp2f(m - mn); lsum *= al;
#pragma unroll
                        for (int dt = 0; dt < 8; ++dt) o[dt] = o[dt] * al; }
                    m = mn;
                    float p[8];
#pragma unroll
                    for (int e = 0; e < 8; ++e) { p[e] = tv[e] > -1e29f ? __builtin_amdgcn_exp2f(tv[e] - m) : 0.f; lsum += p[e]; }
                    union { att_s8 v; unsigned w[4]; } pf;
                    pf.w[0] = pg8::cvt_pk_bf16(p[0], p[1]); pf.w[1] = pg8::cvt_pk_bf16(p[2], p[3]); pf.w[2] = pg8::cvt_pk_bf16(p[4], p[5]); pf.w[3] = pg8::cvt_pk_bf16(p[6], p[7]);
                    { const int swv = 4 * (g & 1) + (i16 >> 2); LAS unsigned char* vp = kb + 16384 + (koff + 4 * g + (i16 >> 2)) * 256 + (i16 & 3) * 8;
#pragma unroll
                      for (int dt = 0; dt < 8; ++dt) { const int off = (dt ^ swv) * 32;
                          const att_s4 va = __builtin_amdgcn_ds_read_tr16_b64_v4i16((LAS att_s4*)(vp + off)), vb = __builtin_amdgcn_ds_read_tr16_b64_v4i16((LAS att_s4*)(vp + 4096 + off));
                          const att_s8 vf = __builtin_shufflevector(va, vb, 0, 1, 2, 3, 4, 5, 6, 7);
                          o[dt] = __builtin_amdgcn_mfma_f32_16x16x32_bf16(vf, pf.v, o[dt], 0, 0, 0); } }
                }
            }
            if (t + 1 < ntiles) ATT_WRITE((t + 1) & 1);
            __syncthreads();
        }
#undef ATT_ROW0
#undef ATT_LOAD
#undef ATT_WRITE
        lsum += __shfl_xor(lsum, 16); lsum += __shfl_xor(lsum, 32);
        const float inv = 1.0f / lsum;
        bf16* op = O + (size_t)qrow * D + h * HD + 4 * g;
#pragma unroll
        for (int dt = 0; dt < 8; ++dt) { v2u w; w.x = pg8::cvt_pk_bf16(o[dt][0] * inv, o[dt][1] * inv); w.y = pg8::cvt_pk_bf16(o[dt][2] * inv, o[dt][3] * inv); *(v2u*)(op + 16 * dt) = w; }
    }
    __syncthreads();
}

constexpr int NPHASE = 3 + 7 * DEPTH;
__global__ void __launch_bounds__(NWAVES * 64, 2) fwd(Args args) {
    extern __shared__ __attribute__((aligned(16))) unsigned char lds[];
    Frame F;
    F.lds = (LAS unsigned char*)lds;
    F.MISC = (volatile LAS unsigned*)(F.lds + MISC_OFF);
    F.tid = threadIdx.x; F.lane = F.tid & 63; F.wave = __builtin_amdgcn_readfirstlane(F.tid >> 6);
    F.G = gridDim.x; { const int bx = blockIdx.x; F.vcu = (F.G % 8 == 0) ? (bx % 8) * (F.G / 8) + bx / 8 : bx; }
    unsigned char* ws = args.ws;
    F.ctl = (gu32*)(ws + WS_CTL);
    for (int u = F.tid; u < (LDS_BYTES - LDSCTL_OFF) / 4; u += NWAVES * 64) ((LAS unsigned*)(F.lds + LDSCTL_OFF))[u] = 0u;
    __syncthreads();
    const int lo = args.ph_lo, hi = args.ph_hi;
    const bool multi = (hi - lo) > 1;
    XcdBarrier bar; bar.bar = (unsigned*)(F.ctl + CW_BAR); bar.x = 0; bar.st = nullptr;
    if (multi) bar = xcd_barrier_post((unsigned*)(F.ctl + CW_BAR), F.MISC + 8);
#define IN(k) (lo <= (k) && (k) < hi)
#define SEAM(k) do { if (IN((k) + 1)) xcd_barrier(bar); } while (0)

    float* const X = (float*)(ws + WS_X);
    const float* const ADA = (const float*)(ws + WS_ADA);
    bf16* const H = (bf16*)(ws + WS_H);

#ifndef PROBE_ID
#define PROBE_ID 0
#endif
#define NREP(id) ((PROBE_ID) == (id) ? 2 : 1)
    float* const XDUM = (float*)(ws + WS_DUMX); bf16* const HDUM = (bf16*)(ws + WS_DUMH);
    if (IN(0)) { for (int rep = 0; rep < NREP(1); ++rep) { p_ada_partial(F, args); __syncthreads(); p_convert_weights(F, args); p_copy_x(F, args); } SEAM(0); }
    if (IN(1)) { p_ada_reduce(F, args); SEAM(1); }
    if (IN(2)) { p_modulate(F, args, MR, ADA, 0, D); SEAM(2); }

    for (int l = 0; l < DEPTH; ++l) {
        const int pb = 3 + 7 * l;
        const bool use_na = (l & 1) == 0; const int j = l >> 1;
        const int rows = l < 2 ? MR : ML;
        const float* ada_l = ADA + (size_t)l * NCOND * ADAW;
        if (use_na) {
            if (IN(pb + 0)) {
                for (int rep = 0; rep < NREP(2); ++rep) {
                pg8::Gemm g{H, (const bf16*)(ws + WS_WQKV) + (size_t)j * 3 * D * D, MR, 3 * D, D, D, D, 0, 0}; pg8::StaticOrder S; S.init(MR, 3 * D, F.G, (int)blockIdx.x);
                pg8::EpiBf16 E{(bf16*)(ws + WS_QKV), 3 * D};
                pg8::gemm_phase<pg8::EpiBf16, pg8::StaticOrder, true, true>(F.lds + RING_OFF, g, S, E); }
                SEAM(pb + 0);
            }
            if (IN(pb + 1)) { for (int rep = 0; rep < NREP(3); ++rep) p_attention_mfma(F, args, args.na_rpb + (size_t)j * NH * 15 * 31, l == 0); SEAM(pb + 1); }
        } else {
            if (IN(pb + 0)) { for (int rep = 0; rep < NREP(4); ++rep) p_pool(F, args, rows, ada_l); SEAM(pb + 0); }
        }
        if (IN(pb + 2)) {
            for (int rep = 0; rep < NREP(5); ++rep) {
            pg8::Gemm g; pg8::EpiRes E{X, rep == NREP(5) - 1 ? X : XDUM, D, ada_l + 2 * D, ADAW, nullptr, DN_ALPHA};
            if (use_na) g = pg8::Gemm{(const bf16*)(ws + WS_O), (const bf16*)(ws + WS_WO) + (size_t)j * D * D, rows, D, D, D, D, 0, 0};
            else { g = pg8::Gemm{(const bf16*)(ws + WS_O), (const bf16*)(ws + WS_WPOOL) + (size_t)j * D * 512, rows, D, 512, D, 512, 2, 512}; E.colscale = args.pool_scale + (size_t)j * D; }
            pg8::StaticOrder S; S.init(rows, D, F.G, (int)blockIdx.x);
            pg8::gemm_phase<pg8::EpiRes, pg8::StaticOrder, true, true>(F.lds + RING_OFF, g, S, E); }
            SEAM(pb + 2);
        }
        if (IN(pb + 3)) { for (int rep = 0; rep < NREP(6); ++rep) { const bool fin = rep == NREP(6) - 1;
            p_layernorm(F, args, rows, args.ln_mix_g + (size_t)l * D, args.ln_mix_b + (size_t)l * D, fin ? X : XDUM, fin ? H : HDUM, ada_l, 3 * D, 4 * D); } SEAM(pb + 3); }
        if (IN(pb + 4)) {
            for (int rep = 0; rep < NREP(7); ++rep) {
            pg8::Gemm g{H, (const bf16*)(ws + WS_WIN) + (size_t)l * 2 * DFF * D, rows, 2 * DFF, D, D, D, 0, 0}; pg8::StaticOrder S; S.init(rows, 2 * DFF, F.G, (int)blockIdx.x);
            pg8::EpiSwiGLU E{(bf16*)(ws + WS_ACT), DFF};
            pg8::gemm_phase<pg8::EpiSwiGLU, pg8::StaticOrder, true, true>(F.lds + RING_OFF, g, S, E); }
            SEAM(pb + 4);
        }
        if (IN(pb + 5)) {
            for (int rep = 0; rep < NREP(8); ++rep) {
            pg8::Gemm g{(const bf16*)(ws + WS_ACT), (const bf16*)(ws + WS_WOUT) + (size_t)l * D * DFF, rows, D, DFF, DFF, DFF, 0, 0}; pg8::StaticOrder S; S.init(rows, D, F.G, (int)blockIdx.x);
            pg8::EpiRes E{X, rep == NREP(8) - 1 ? X : XDUM, D, ada_l + 5 * D, ADAW, nullptr, DN_ALPHA};
            pg8::gemm_phase<pg8::EpiRes, pg8::StaticOrder, true, true>(F.lds + RING_OFF, g, S, E); }
            SEAM(pb + 5);
        }
        if (IN(pb + 6)) {
            const bool last = (l == DEPTH - 1);
            const int nrows = l < 2 ? MR : ML;
            for (int rep = 0; rep < NREP(6); ++rep) { const bool fin = rep == NREP(6) - 1;
            p_layernorm(F, args, nrows, args.ln_ffn_g + (size_t)l * D, args.ln_ffn_b + (size_t)l * D, fin ? (last ? args.out : X) : XDUM, fin ? H : HDUM, last ? nullptr : ada_l + (size_t)NCOND * ADAW, 0, D); }
            if (!last) SEAM(pb + 6);
        }
    }
#undef IN
#undef SEAM
}

extern "C" void kernel_launch(void* const* d_in, const int* in_sizes, int n_in, void* d_out, int out_size, void* d_ws, size_t ws_size, hipStream_t stream) {
    static int grid = 0;
    if (grid == 0) {
        if (n_in != 17 || out_size != ML * D || ws_size < WS_END) { fprintf(stderr, "kernel_launch: unexpected shapes (n_in %d, out %d, ws %zu); nothing launched\n", n_in, out_size, ws_size); grid = -1; return; }
        int dev = 0, cus = 0, per_cu = 0;
        if (hipGetDevice(&dev) != hipSuccess || hipDeviceGetAttribute(&cus, hipDeviceAttributeMultiprocessorCount, dev) != hipSuccess) { grid = -1; return; }
        if (hipFuncSetAttribute((const void*)fwd, hipFuncAttributeMaxDynamicSharedMemorySize, LDS_BYTES) != hipSuccess) { fprintf(stderr, "kernel_launch: hipFuncSetAttribute failed\n"); grid = -1; return; }
        if (hipOccupancyMaxActiveBlocksPerMultiprocessor(&per_cu, (const void*)fwd, NWAVES * 64, LDS_BYTES) != hipSuccess || per_cu < 1)
            fprintf(stderr, "kernel_launch: note: occupancy query reports %d workgroups per CU\n", per_cu);
        (void)hipGetLastError();
        grid = cus;
    }
    if (grid < 0) return;
    if (hipMemsetAsync((char*)d_ws + WS_CTL, 0, CTL_ZERO_BYTES, stream) != hipSuccess) { fprintf(stderr, "kernel_launch: memset failed\n"); return; }
    Args a{};
    a.x = (const float*)d_in[0]; a.c = (const float*)d_in[1]; a.ctx = (const float*)d_in[2]; a.c_ctx = (const float*)d_in[3]; a.ada_w = (const float*)d_in[4]; a.ada_b = (const float*)d_in[5];
    a.ln_mix_g = (const float*)d_in[6]; a.ln_mix_b = (const float*)d_in[7]; a.ln_ffn_g = (const float*)d_in[8]; a.ln_ffn_b = (const float*)d_in[9];
    a.na_w_qkv = (const float*)d_in[10]; a.na_w_o = (const float*)d_in[11]; a.na_rpb = (const float*)d_in[12]; a.pool_w = (const float*)d_in[13]; a.pool_scale = (const float*)d_in[14];
    a.ffn_w_in = (const float*)d_in[15]; a.ffn_w_out = (const float*)d_in[16];
    a.out = (float*)d_out; a.ws = (unsigned char*)d_ws;
#if MK_ONE_LAUNCH
    a.ph_lo = 0; a.ph_hi = NPHASE;
    hipLaunchKernelGGL(fwd, dim3(grid), dim3(NWAVES * 64), LDS_BYTES, stream, a);
#else
    for (int p = 0; p < NPHASE; ++p) {
        const int l = (p - 3) / 7, s = (p - 3) % 7;
        if (p >= 3 && (l & 1) == 1 && s == 1) continue;
        a.ph_lo = p; a.ph_hi = p + 1;
        hipLaunchKernelGGL(fwd, dim3(grid), dim3(NWAVES * 64), LDS_BYTES, stream, a);
    }
#endif
    const hipError_t le = hipPeekAtLastError();
    if (le != hipSuccess) fprintf(stderr, "kernel_launch: launch failed: %s\n", hipGetErrorName(le));
}
```

```cpp
#include <hip/hip_runtime.h>
#include <cstdio>
#include <cstdint>

#ifndef MK_ONE_LAUNCH
#define MK_ONE_LAUNCH 1
#endif

namespace pg8 {
#define PG8_LAS __attribute__((address_space(3)))
typedef unsigned short bf16_t;
typedef short bf16x8 __attribute__((ext_vector_type(8)));
typedef float f32x4 __attribute__((ext_vector_type(4)));
typedef unsigned u32x4 __attribute__((ext_vector_type(4)));
constexpr int BM = 256, BK = 64, HALF = 128, HTB = HALF * BK * 2  , STAGE_BYTES = 8 * HTB, NXCD = 8, WGM = 8;

__host__ __device__ __forceinline__ int lds_byte(int r, int c) { const int st = (r >> 4) * 2 + (c >> 5), rr = r & 15, cc = c & 31, ob = rr * 64 + cc * 2; return st * 1024 + (ob ^ (((ob >> 9) & 1) << 5)); }
__host__ __device__ __forceinline__ void stage_rc(int b, int& R, int& C) { const int st = b / 1024, sb = b % 1024, swz = sb ^ (((sb >> 9) & 1) << 5); R = (st >> 1) * 16 + swz / 64; C = (st & 1) * 32 + (swz % 64) / 2; }
__host__ __device__ __forceinline__ int perm32(int rho) { const int n = rho >> 4, i = rho & 15; return 8 * (i >> 2) + 4 * n + (i & 3); }

__device__ __forceinline__ int opaque_v(int v) { asm volatile("" : "+v"(v)); return v; }
__device__ __forceinline__ int opaque_s(int v) { asm volatile("" : "+s"(v)); return v; }
struct Unit { int pm, pn, ks; };
struct Gemm { const bf16_t* A; const bf16_t* Bt; int M, N, K, lda, ldb, grp_pn, grp_k; };

struct StaticOrder {
    int nM, nN, nwg, G, c;
    __host__ __device__ void init(int M, int N, int G_, int c_) { nM = M / BM; nN = N / BM; nwg = nM * nN; G = G_; c = c_; }
    __host__ __device__ bool next(int i, Unit& u) const {
        const long L = (long)i * G + c; if (L >= nwg) return false;
        int wgid = (int)L; { const int q = nwg / NXCD, r = nwg % NXCD, xcd = wgid % NXCD, off = wgid / NXCD; wgid = (xcd < r ? xcd * (q + 1) : r * (q + 1) + (xcd - r) * q) + off; }
        const int nig = WGM * nN, gid = wgid / nig, fm = gid * WGM, gsz = (nM - fm) < WGM ? (nM - fm) : WGM;
        u.pm = fm + ((wgid % nig) % gsz); u.pn = (wgid % nig) / gsz; u.ks = 0; return true;
    }
    __device__ __forceinline__ void a_ready(const Unit&) const {}
    __device__ __forceinline__ void done(const Unit&) const {}
};

struct SplitOrder {
    int pm0, nN, nsplit, nunits, G, c;
    __host__ __device__ void init(int pm0_, int nM, int nN_, int nsplit_, int G_, int c_) { pm0 = pm0_; nN = nN_; nsplit = nsplit_; nunits = nM * nN_ * nsplit_; G = G_; c = c_; }
    __host__ __device__ bool next(int i, Unit& u) const { const long L = (long)i * G + c; if (L >= nunits) return false; const int l = (int)L, tile = l / nsplit; u.ks = l % nsplit; u.pn = tile % nN; u.pm = pm0 + tile / nN; return true; }
    __device__ __forceinline__ void a_ready(const Unit&) const {}
    __device__ __forceinline__ void done(const Unit&) const {}
};

__device__ __forceinline__ unsigned cvt_pk_bf16(float lo, float hi) { unsigned r; asm volatile("v_cvt_pk_bf16_f32 %0, %1, %2" : "=v"(r) : "v"(lo), "v"(hi)); return r; }

struct EpiBf16 {
    static constexpr bool PERM = true, AFTER_DRAIN = false;
    bf16_t* O; int ldc;
    __device__ __forceinline__ void operator()(const f32x4 (&acc)[2][2][4][2], const Unit& u, int wr, int wc, int fr, int fq) const {
        const int row0 = u.pm * BM + wr * 64 + fr; const int col0 = u.pn * BM + wc * 32 + 8 * fq;
#pragma unroll
        for (int ai = 0; ai < 2; ++ai)
#pragma unroll
            for (int m = 0; m < 4; ++m) { bf16_t* rowp = O + (size_t)(row0 + ai * HALF + m * 16) * ldc + col0;
#pragma unroll
                for (int bj = 0; bj < 2; ++bj) { const f32x4 v0 = acc[ai][bj][m][0], v1 = acc[ai][bj][m][1];
                    u32x4 w; w.x = cvt_pk_bf16(v0[0], v0[1]); w.y = cvt_pk_bf16(v0[2], v0[3]); w.z = cvt_pk_bf16(v1[0], v1[1]); w.w = cvt_pk_bf16(v1[2], v1[3]);
                    *(u32x4*)(rowp + bj * HALF) = w; } }
    }
};
struct EpiSwiGLU {
    static constexpr bool PERM = true, AFTER_DRAIN = false;
    bf16_t* O; int ldc;
    __device__ __forceinline__ float act(float g, float u) const { return g * u * __builtin_amdgcn_rcpf(1.0f + __builtin_amdgcn_exp2f(g * -1.44269504089f)); }
    __device__ __forceinline__ void operator()(const f32x4 (&acc)[2][2][4][2], const Unit& u, int wr, int wc, int fr, int fq) const {
        const int row0 = u.pm * BM + wr * 64 + fr; const int col0 = u.pn * HALF + wc * 32 + 8 * fq;
#pragma unroll
        for (int ai = 0; ai < 2; ++ai)
#pragma unroll
            for (int m = 0; m < 4; ++m) { bf16_t* rowp = O + (size_t)(row0 + ai * HALF + m * 16) * ldc + col0;
                const f32x4 g0 = acc[ai][0][m][0], g1 = acc[ai][0][m][1], u0 = acc[ai][1][m][0], u1 = acc[ai][1][m][1];
                u32x4 w; w.x = cvt_pk_bf16(act(g0[0], u0[0]), act(g0[1], u0[1])); w.y = cvt_pk_bf16(act(g0[2], u0[2]), act(g0[3], u0[3]));
                w.z = cvt_pk_bf16(act(g1[0], u1[0]), act(g1[1], u1[1])); w.w = cvt_pk_bf16(act(g1[2], u1[2]), act(g1[3], u1[3]));
                *(u32x4*)rowp = w; }
    }
};
struct EpiRes {
    static constexpr bool PERM = false, AFTER_DRAIN = false;
    float* X; float* Xo; int ldx; const float* gate; int gate_stride; const float* colscale; float alpha;
    __device__ __forceinline__ void operator()(const f32x4 (&acc)[2][2][4][2], const Unit& u, int wr, int wc, int fr, int fq) const {
        const int row0 = u.pm * BM + wr * 64 + fr, col0 = u.pn * BM + wc * 32 + 4 * fq;
        const int cond = u.pm < 64 ? (u.pm >> 4) : 4;
        const float* gp = gate + (size_t)cond * gate_stride + col0;
        f32x4 gv[2][2];
#pragma unroll
        for (int bj = 0; bj < 2; ++bj)
#pragma unroll
            for (int n = 0; n < 2; ++n) { gv[bj][n] = *(const f32x4*)(gp + bj * HALF + n * 16); if (colscale) gv[bj][n] = gv[bj][n] * *(const f32x4*)(colscale + col0 + bj * HALF + n * 16); }
#pragma unroll
        for (int ai = 0; ai < 2; ++ai) {
            f32x4 xv[4][2][2];
#pragma unroll
            for (int m = 0; m < 4; ++m) { const float* rowp = X + (size_t)(row0 + ai * HALF + m * 16) * ldx + col0;
#pragma unroll
                for (int bj = 0; bj < 2; ++bj)
#pragma unroll
                    for (int n = 0; n < 2; ++n) xv[m][bj][n] = *(const f32x4*)(rowp + bj * HALF + n * 16); }
#pragma unroll
            for (int m = 0; m < 4; ++m) { float* rowo = Xo + (size_t)(row0 + ai * HALF + m * 16) * ldx + col0;
#pragma unroll
                for (int bj = 0; bj < 2; ++bj)
#pragma unroll
                    for (int n = 0; n < 2; ++n) *(f32x4*)(rowo + bj * HALF + n * 16) = xv[m][bj][n] * alpha + gv[bj][n] * acc[ai][bj][m][n]; }
            asm volatile("" ::: "memory"); }
    }
};

struct EpiPart {
    static constexpr bool PERM = false, AFTER_DRAIN = false;
    float* P; int ldp, pm_base; size_t slice_stride;
    __device__ __forceinline__ void operator()(const f32x4 (&acc)[2][2][4][2], const Unit& u, int wr, int wc, int fr, int fq) const {
        const int row0 = (u.pm - pm_base) * BM + wr * 64 + fr, col0 = u.pn * BM + wc * 32 + 4 * fq; float* base = P + (size_t)u.ks * slice_stride;
#pragma unroll
        for (int ai = 0; ai < 2; ++ai)
#pragma unroll
            for (int m = 0; m < 4; ++m) { float* rowp = base + (size_t)(row0 + ai * HALF + m * 16) * ldp + col0;
#pragma unroll
                for (int bj = 0; bj < 2; ++bj)
#pragma unroll
                    for (int n = 0; n < 2; ++n) *(f32x4*)(rowp + bj * HALF + n * 16) = acc[ai][bj][m][n]; }
    }
};

template <class Epi, class Sched, bool ALIGN_EPI = false, bool SP2 = false>
__device__ __forceinline__ void gemm_phase(PG8_LAS unsigned char* lds, const Gemm g, const Sched& S, const Epi& E) {
    const int tid = opaque_v(threadIdx.x), wid = __builtin_amdgcn_readfirstlane(tid >> 6), lane = tid & 63, wr = wid >> 2, wc = wid & 3, fr = lane & 15, fq = lane >> 4;
    const int K = g.K, nt = K / BK;
    unsigned voffA[2], voffB[2];
#pragma unroll
    for (int i = 0; i < 2; ++i) { int R, C; stage_rc(tid * 16 + i * 8192, R, C); const int Rb = Epi::PERM ? ((R & ~31) + perm32(R & 31)) : R;
        voffA[i] = (unsigned)(R * g.lda + C) * 2u; voffB[i] = (unsigned)(Rb * g.ldb + C) * 2u; }
    const size_t kstep = (size_t)(BK * 2);
    const size_t hstepA = (size_t)HALF * g.lda * 2, hstepB = (size_t)HALF * g.ldb * 2;
    const size_t tstepA = 2 * hstepA, tstepB = 2 * hstepB;
    const unsigned ldsw = (unsigned)wid * 1024u;
    const int aoff = lds_byte(wr * 64 + fr, fq * 8), boff = lds_byte(wc * 32 + fr, fq * 8);
#define PG8_SA(b, h) (((b) * 2 + (h)) * HTB)
#define PG8_SB(b, h) ((4 + (b) * 2 + (h)) * HTB)
#define PG8_STAGE(bufoff, gbase, voff) do { _Pragma("unroll") for (int _i = 0; _i < 2; ++_i) \
        __builtin_amdgcn_global_load_lds((const unsigned*)((const char*)(gbase) + (voff)[_i]), (PG8_LAS unsigned*)(lds + (bufoff) + ldsw + _i * 8192), 16, 0, 0); } while (0)
#define PG8_LDA(dst, b, h) do { _Pragma("unroll") for (int m = 0; m < 4; ++m) _Pragma("unroll") for (int k = 0; k < 2; ++k) dst[m][k] = *(const PG8_LAS bf16x8*)(lds + PG8_SA(b, h) + aoff + m * 2048 + k * 1024); } while (0)
#define PG8_LDB(dst, b, h) do { _Pragma("unroll") for (int n = 0; n < 2; ++n) _Pragma("unroll") for (int k = 0; k < 2; ++k) dst[n][k] = *(const PG8_LAS bf16x8*)(lds + PG8_SB(b, h) + boff + n * 2048 + k * 1024); } while (0)
#define PG8_MMA(ai, bj, At, Bt) do { __builtin_amdgcn_s_setprio(1); _Pragma("unroll") for (int m = 0; m < 4; ++m) _Pragma("unroll") for (int n = 0; n < 2; ++n) _Pragma("unroll") for (int k = 0; k < 2; ++k) \
        acc[ai][bj][m][n] = __builtin_amdgcn_mfma_f32_16x16x32_bf16(Bt[n][k], At[m][k], acc[ai][bj][m][n], 0, 0, 0); __builtin_amdgcn_s_setprio(0); } while (0)
#define PG8_WAIT_V(n) asm volatile("s_waitcnt vmcnt(" #n ")" ::: "memory")
#define PG8_WAIT_L(n) asm volatile("s_waitcnt lgkmcnt(" #n ")" ::: "memory")
#define PG8_BAR __builtin_amdgcn_s_barrier()
#define PG8_SCHED __builtin_amdgcn_sched_barrier(0)
#define PG8_AOF(u) ((size_t)(u).pm * tstepA + (size_t)(u).ks * (size_t)K * 2 + (g.grp_pn ? (size_t)((u).pn / g.grp_pn) * (size_t)g.grp_k * 2 : (size_t)0))
#define PG8_BOF(u) ((size_t)(u).pn * tstepB + (size_t)(u).ks * (size_t)K * 2)
    Unit cur, nxt; int ui = 0;
    if (!S.next(0, cur)) return;
    f32x4 acc[2][2][4][2];
#pragma unroll
    for (int a = 0; a < 2; ++a)
#pragma unroll
        for (int b = 0; b < 2; ++b)
#pragma unroll
            for (int m = 0; m < 4; ++m)
#pragma unroll
                for (int n = 0; n < 2; ++n) acc[a][b][m][n] = (f32x4){0.f, 0.f, 0.f, 0.f};
    bf16x8 At[4][2], B0[2][2], B1[2][2];
    const char* cA = (const char*)g.A + PG8_AOF(cur); const char* cB = (const char*)g.Bt + PG8_BOF(cur);
    S.a_ready(cur);
    if constexpr (SP2) {
        PG8_STAGE(PG8_SB(0, 0), cB, voffB); PG8_STAGE(PG8_SB(0, 1), cB + hstepB, voffB); PG8_STAGE(PG8_SA(0, 0), cA, voffA); PG8_STAGE(PG8_SA(0, 1), cA + hstepA, voffA);
        if (wr == 1) PG8_BAR;
        PG8_WAIT_V(2); PG8_BAR;
        PG8_STAGE(PG8_SB(1, 0), cB + kstep, voffB); PG8_STAGE(PG8_SA(1, 0), cA + kstep, voffA); PG8_STAGE(PG8_SB(1, 1), cB + hstepB + kstep, voffB);
        PG8_WAIT_V(6); PG8_BAR;
    } else {
        PG8_STAGE(PG8_SB(0, 0), cB, voffB); PG8_STAGE(PG8_SA(0, 0), cA, voffA); PG8_STAGE(PG8_SB(0, 1), cB + hstepB, voffB); PG8_STAGE(PG8_SA(0, 1), cA + hstepA, voffA);
        if (wr == 1) PG8_BAR;
        PG8_WAIT_V(4); PG8_BAR;
        PG8_STAGE(PG8_SB(1, 0), cB + kstep, voffB); PG8_STAGE(PG8_SA(1, 0), cA + kstep, voffA); PG8_STAGE(PG8_SB(1, 1), cB + hstepB + kstep, voffB);
        PG8_WAIT_V(6); PG8_BAR;
    }
    for (;;) {
        const bool has_next = S.next(ui + 1, nxt);
        const char* nA = has_next ? (const char*)g.A + PG8_AOF(nxt) : cA; const char* nB = has_next ? (const char*)g.Bt + PG8_BOF(nxt) : cB;
        for (int t = 0; t < nt; t += 2) {
            const bool last = (t == nt - 2);
            const char* a1 = cA + (size_t)(t + 1) * kstep;
            const char* a2 = last ? nA : cA + (size_t)(t + 2) * kstep; const char* b2 = last ? nB : cB + (size_t)(t + 2) * kstep;
            const char* a3 = a2 + kstep; const char* b3 = b2 + kstep;
            if (last && has_next) S.a_ready(nxt);
            if constexpr (SP2) {
            PG8_LDB(B0, 0, 0); PG8_LDB(B1, 0, 1); PG8_SCHED; PG8_LDA(At, 0, 0); PG8_STAGE(PG8_SA(1, 1), a1 + hstepA, voffA);
            PG8_WAIT_V(8); PG8_WAIT_L(0); PG8_BAR; PG8_MMA(0, 0, At, B0); PG8_MMA(0, 1, At, B1); PG8_BAR; PG8_SCHED;
            PG8_LDA(At, 0, 1); PG8_STAGE(PG8_SB(0, 0), b2, voffB); PG8_STAGE(PG8_SB(0, 1), b2 + hstepB, voffB); PG8_STAGE(PG8_SA(0, 0), a2, voffA);
            PG8_WAIT_V(8); PG8_WAIT_L(0); PG8_BAR; PG8_MMA(1, 0, At, B0); PG8_MMA(1, 1, At, B1); PG8_BAR; PG8_SCHED;
            PG8_LDB(B0, 1, 0); PG8_LDB(B1, 1, 1); PG8_SCHED; PG8_LDA(At, 1, 0); PG8_STAGE(PG8_SA(0, 1), a2 + hstepA, voffA);
            PG8_WAIT_V(8); PG8_WAIT_L(0); PG8_BAR; PG8_MMA(0, 0, At, B0); PG8_MMA(0, 1, At, B1); PG8_BAR; PG8_SCHED;
            PG8_LDA(At, 1, 1); PG8_STAGE(PG8_SB(1, 0), b3, voffB); PG8_STAGE(PG8_SB(1, 1), b3 + hstepB, voffB); PG8_STAGE(PG8_SA(1, 0), a3, voffA);
            PG8_WAIT_V(8); PG8_WAIT_L(0); PG8_BAR; PG8_MMA(1, 0, At, B0); PG8_MMA(1, 1, At, B1); PG8_BAR; PG8_SCHED;
            } else {
            PG8_LDB(B0, 0, 0); PG8_SCHED; PG8_LDA(At, 0, 0); PG8_STAGE(PG8_SA(1, 1), a1 + hstepA, voffA);
            PG8_WAIT_L(8); PG8_BAR; PG8_WAIT_L(0); PG8_MMA(0, 0, At, B0); PG8_BAR; PG8_SCHED;
            PG8_LDB(B1, 0, 1); PG8_STAGE(PG8_SB(0, 0), b2, voffB);
            PG8_BAR; PG8_WAIT_L(0); PG8_MMA(0, 1, At, B1); PG8_BAR;
            PG8_LDA(At, 0, 1); PG8_STAGE(PG8_SA(0, 0), a2, voffA);
            PG8_BAR; PG8_WAIT_L(0); PG8_MMA(1, 0, At, B0); PG8_BAR; PG8_SCHED;
            PG8_STAGE(PG8_SB(0, 1), b2 + hstepB, voffB);
            PG8_WAIT_V(6); PG8_BAR; PG8_MMA(1, 1, At, B1); PG8_BAR;
            PG8_LDB(B0, 1, 0); PG8_SCHED; PG8_LDA(At, 1, 0); PG8_STAGE(PG8_SA(0, 1), a2 + hstepA, voffA);
            PG8_WAIT_L(8); PG8_BAR; PG8_WAIT_L(0); PG8_MMA(0, 0, At, B0); PG8_BAR; PG8_SCHED;
            PG8_LDB(B1, 1, 1); PG8_STAGE(PG8_SB(1, 0), b3, voffB);
            PG8_BAR; PG8_WAIT_L(0); PG8_MMA(0, 1, At, B1); PG8_BAR;
            PG8_LDA(At, 1, 1); PG8_STAGE(PG8_SA(1, 0), a3, voffA);
            PG8_BAR; PG8_WAIT_L(0); PG8_MMA(1, 0, At, B0); PG8_BAR; PG8_SCHED;
            PG8_STAGE(PG8_SB(1, 1), b3 + hstepB, voffB);
            PG8_WAIT_V(6); PG8_BAR; PG8_MMA(1, 1, At, B1); PG8_BAR;
            }
        }
        if constexpr (ALIGN_EPI) { if (wr == 0) PG8_BAR; }
        if constexpr (!Epi::AFTER_DRAIN) { E(acc, cur, wr, wc, fr, fq); S.done(cur); }
        if (!has_next) break;
#pragma unroll
        for (int a = 0; a < 2; ++a)
#pragma unroll
            for (int b = 0; b < 2; ++b)
#pragma unroll
                for (int m = 0; m < 4; ++m)
#pragma unroll
                    for (int n = 0; n < 2; ++n) acc[a][b][m][n] = (f32x4){0.f, 0.f, 0.f, 0.f};
        cur = nxt; cA = nA; cB = nB; ++ui;
        if constexpr (ALIGN_EPI) { if (wr == 1) PG8_BAR; }
    }
    PG8_WAIT_V(0);
    if constexpr (!ALIGN_EPI) { if (wr == 0) PG8_BAR; }
    PG8_BAR;
#undef PG8_AOF
#undef PG8_BOF
#undef PG8_SA
#undef PG8_SB
#undef PG8_STAGE
#undef PG8_LDA
#undef PG8_LDB
#undef PG8_MMA
#undef PG8_WAIT_V
#undef PG8_WAIT_L
#undef PG8_BAR
#undef PG8_SCHED
}
}

constexpr int NWAVES = 8;
constexpr int D = 2048, BATCH = 4, SEQ = 4096, DEPTH = 4, CTXL = 256, GRIDW = 64, NH = 16, HD = 128;
constexpr int DFF = 5632, NADA = 6;
constexpr int ML = BATCH * SEQ;
constexpr int MC = BATCH * CTXL;
constexpr int MR = ML + MC;
constexpr int NCOND = BATCH + 1;
constexpr int ADAW = NADA * D;
constexpr float LN_EPS = 1e-5f;
constexpr float DN_ALPHA = 1.6817928305074290f;
constexpr float ATT_SCALE = 0.08838834764831845f;
constexpr int KSPLIT = 32;

constexpr size_t MiB = 1u << 20;
constexpr size_t WS_CTL = 0, CTL_ZERO_BYTES = 1 * MiB;
constexpr size_t WS_ADA = 1 * MiB;
constexpr size_t WS_PART = 2 * MiB;
constexpr size_t WS_WQKV = 34 * MiB;
constexpr size_t WS_WO = 82 * MiB;
constexpr size_t WS_WPOOL = 98 * MiB;
constexpr size_t WS_WIN = 102 * MiB;
constexpr size_t WS_WOUT = 278 * MiB;
constexpr size_t WS_X = 366 * MiB;
constexpr size_t WS_H = 502 * MiB;
constexpr size_t WS_QKV = 570 * MiB;
constexpr size_t WS_O = 774 * MiB;
constexpr size_t WS_ACT = 842 * MiB;
constexpr size_t WS_DUMX = 1030 * MiB;
constexpr size_t WS_DUMH = 1166 * MiB;
constexpr size_t WS_END = 1234 * MiB;
constexpr int CW_TMO = 0, CW_CODE = 1;
constexpr int CW_BAR = 4096;

constexpr int RING_OFF = 0, RING_BYTES = 131072;
constexpr int LDSCTL_OFF = RING_BYTES, MISC_OFF = LDSCTL_OFF + 320;
constexpr int LDS_BYTES = 147456;

#define GAS __attribute__((address_space(1)))
#define LAS __attribute__((address_space(3)))
typedef unsigned short bf16;
typedef unsigned v4u __attribute__((ext_vector_type(4)));
typedef unsigned v2u __attribute__((ext_vector_type(2)));
typedef float f32x4 __attribute__((ext_vector_type(4)));
typedef GAS unsigned gu32;
#define RLX_AGENT __ATOMIC_RELAXED, __HIP_MEMORY_SCOPE_AGENT
#define LDS_WAIT() asm volatile("s_waitcnt lgkmcnt(0)" ::: "memory")
#define VM_WAIT() asm volatile("s_waitcnt vmcnt(0)" ::: "memory")
__device__ __forceinline__ unsigned f2bf(float f) { unsigned u = __builtin_bit_cast(unsigned, f); return (u + 0x7fffu + ((u >> 16) & 1u)) >> 16; }
__device__ __forceinline__ unsigned pk2(float lo, float hi) { return f2bf(lo) | (f2bf(hi) << 16); }
__device__ __forceinline__ float bf_lo(unsigned w) { return __builtin_bit_cast(float, w << 16); }
__device__ __forceinline__ float bf_hi(unsigned w) { return __builtin_bit_cast(float, w & 0xffff0000u); }

#define XB_TMO      128
#define XB_XCNT(j)  (256  + 64 * (j))
#define XB_XSUB(j)  (1280 + 64 * (j))
#define XB_XGEN(j)  (2304 + 64 * (j))
#define XB_TOP      3328
#define XB_TOPGEN   3392
#define XCD_BAR_WORDS 3456
#define XB_SPIN_CAP (1u << 18)

__device__ __forceinline__ unsigned xb_ld(unsigned* p)              { return __hip_atomic_load(p, __ATOMIC_RELAXED, __HIP_MEMORY_SCOPE_AGENT); }
__device__ __forceinline__ unsigned xb_add(unsigned* p, unsigned v) { return __hip_atomic_fetch_add(p, v, __ATOMIC_RELAXED, __HIP_MEMORY_SCOPE_AGENT); }
__device__ __forceinline__ unsigned xb_xcc_id() { return (unsigned)__builtin_amdgcn_s_getreg((3 << 11) | 20) & 0xFu; }
#define XB_SPIN(cond, bar) do { unsigned _sp = 0; while (cond) { __builtin_amdgcn_s_sleep(1); \
    if ((++_sp & 255u) == 0u) { if (xb_ld(&(bar)[XB_TMO])) break; if (_sp > XB_SPIN_CAP) { atomicAdd(&(bar)[XB_TMO], 1u); break; } } } } while (0)

struct XcdBarrier { unsigned* bar; unsigned x; volatile LAS unsigned* st; };

__device__ __forceinline__ XcdBarrier xcd_barrier_post(unsigned* bar, volatile LAS unsigned* st) {
    XcdBarrier b; b.bar = bar; b.x = xb_xcc_id(); b.st = st;
    if (threadIdx.x == 0) (void)xb_add(&bar[XB_XCNT(b.x)], 1u);
    return b;
}
__device__ __forceinline__ void xcd_barrier_complete(unsigned* bar, unsigned x, unsigned& nloc, unsigned& nx) {
    const unsigned G = gridDim.x * gridDim.y * gridDim.z;
    unsigned sum, cnt, mine, sp = 0u;
    for (;;) {
        sum = 0u; cnt = 0u; mine = 0u;
#pragma unroll
        for (unsigned j = 0; j < 16; ++j) { const unsigned c = xb_ld(&bar[XB_XCNT(j)]); sum += c; cnt += (c > 0u) ? 1u : 0u; mine = (j == x) ? c : mine; }
        if (sum == G) break;
        __builtin_amdgcn_s_sleep(1);
        if ((++sp & 255u) == 0u) { if (xb_ld(&bar[XB_TMO])) break; if (sp > XB_SPIN_CAP) { atomicAdd(&bar[XB_TMO], 1u); break; } }
    }
    nloc = mine > 0u ? mine : 1u; nx = cnt > 0u ? cnt : 1u;
}
__device__ __forceinline__ void xcd_barrier(const XcdBarrier& b) {
    asm volatile("s_waitcnt vmcnt(0)" ::: "memory");
    __syncthreads();
    if (threadIdx.x == 0) {
        unsigned* bar = b.bar;
        __builtin_amdgcn_s_waitcnt(0);
        unsigned nloc = b.st[0], nx = b.st[1];
        if (nloc == 0u) { xcd_barrier_complete(bar, b.x, nloc, nx); b.st[0] = nloc; b.st[1] = nx; }
        const unsigned old = xb_add(&bar[XB_XSUB(b.x)], 1u);
        const unsigned gen = old / nloc;
        if (old + 1u == (gen + 1u) * nloc) {
            __builtin_amdgcn_fence(__ATOMIC_RELEASE, "agent");
            asm volatile("s_waitcnt vmcnt(0)" ::: "memory");
            const unsigned og = xb_add(&bar[XB_TOP], 1u);
            const unsigned tg = og / nx;
            if (og + 1u == (tg + 1u) * nx) xb_add(&bar[XB_TOPGEN], 1u);
            else XB_SPIN(xb_ld(&bar[XB_TOPGEN]) == tg, bar);
            __builtin_amdgcn_fence(__ATOMIC_ACQUIRE, "agent");
            xb_add(&bar[XB_XGEN(b.x)], 1u);
            asm volatile("s_waitcnt vmcnt(0)" ::: "memory");
        } else {
            XB_SPIN(xb_ld(&bar[XB_XGEN(b.x)]) == gen, bar);
            __builtin_amdgcn_fence(__ATOMIC_ACQUIRE, "agent");
            asm volatile("s_waitcnt vmcnt(0)" ::: "memory");
        }
    }
    __syncthreads();
}

struct Args {
    const float *x, *c, *ctx, *c_ctx, *ada_w, *ada_b, *ln_mix_g, *ln_mix_b, *ln_ffn_g, *ln_ffn_b, *na_w_qkv, *na_w_o, *na_rpb, *pool_w, *pool_scale, *ffn_w_in, *ffn_w_out;
    float* out; unsigned char* ws; int ph_lo, ph_hi;
};
struct Frame {
    LAS unsigned char* lds;
    volatile LAS unsigned* MISC;
    gu32* ctl;
    int tid, lane, wave;
    int vcu, G;
};

__device__ __forceinline__ float wave_sum(float v) {
#pragma unroll
    for (int o = 1; o < 64; o <<= 1) v += __shfl_xor(v, o);
    return v;
}
__device__ __forceinline__ float silu_f(float v) { return v / (1.0f + __expf(-v)); }

__device__ __forceinline__ void transpose_item(const float* W, int N, bf16* WT, int ldt, int drow0, LAS float* scr, int k0, int n0, int lane) {
#pragma unroll 8
    for (int i = 0; i < 32; ++i) { const int kk = 2 * i + (lane >> 5); scr[kk * 33 + (lane & 31)] = W[(size_t)(k0 + kk) * N + n0 + (lane & 31)]; }
    LDS_WAIT(); asm volatile("" ::: "memory");
    const int c = lane & 7;
#pragma unroll
    for (int j = 0; j < 4; ++j) { const int n = (lane >> 3) + 8 * j; const LAS float* s = scr + (8 * c) * 33 + n;
        v4u o; o.x = pk2(s[0 * 33], s[1 * 33]); o.y = pk2(s[2 * 33], s[3 * 33]); o.z = pk2(s[4 * 33], s[5 * 33]); o.w = pk2(s[6 * 33], s[7 * 33]);
        *(GAS v4u*)(WT + (size_t)(drow0 + n) * ldt + k0 + 8 * c) = o; }
    LDS_WAIT(); asm volatile("" ::: "memory");
}

__device__ __forceinline__ void p_convert_weights(Frame F, const Args& a) {
    F.tid = pg8::opaque_v(F.tid); F.lane = F.tid & 63; F.wave = pg8::opaque_s(F.wave); F.vcu = pg8::opaque_s(F.vcu); F.G = pg8::opaque_s(F.G);
    LAS float* scr = (LAS float*)(F.lds + RING_OFF + F.wave * 16384);
    const int gw = F.vcu * NWAVES + F.wave, NGW = F.G * NWAVES;
    unsigned char* ws = a.ws;
    constexpr int I_QKV = (D / 64) * (3 * D / 32), I_O = (D / 64) * (D / 32), I_POOL = (512 / 64) * (512 / 32), I_IN = (D / 64) * (2 * DFF / 32), I_OUT = (DFF / 64) * (D / 32);
    constexpr int T_QKV = 2 * I_QKV, T_O = 2 * I_O, T_POOL = 8 * I_POOL, T_IN = 4 * I_IN, T_OUT = 4 * I_OUT;
    constexpr int NITEMS = T_QKV + T_O + T_POOL + T_IN + T_OUT;
    for (int it = gw; it < NITEMS; it += NGW) {
        int r = it;
        if (r < T_QKV) { const int j = r / I_QKV, q = r % I_QKV, nblk = 3 * D / 32, kb = q / nblk, nb = q % nblk;
            transpose_item(a.na_w_qkv + (size_t)j * D * 3 * D, 3 * D, (bf16*)(ws + WS_WQKV) + (size_t)j * 3 * D * D, D, 32 * nb, scr, 64 * kb, 32 * nb, F.lane); continue; } r -= T_QKV;
        if (r < T_O) { const int j = r / I_O, q = r % I_O, nblk = D / 32, kb = q / nblk, nb = q % nblk;
            transpose_item(a.na_w_o + (size_t)j * D * D, D, (bf16*)(ws + WS_WO) + (size_t)j * D * D, D, 32 * nb, scr, 64 * kb, 32 * nb, F.lane); continue; } r -= T_O;
        if (r < T_POOL) { const int jg = r / I_POOL, q = r % I_POOL, nblk = 512 / 32, kb = q / nblk, nb = q % nblk;
            transpose_item(a.pool_w + (size_t)jg * 512 * 512, 512, (bf16*)(ws + WS_WPOOL) + (size_t)(jg >> 2) * D * 512, 512, (jg & 3) * 512 + 32 * nb, scr, 64 * kb, 32 * nb, F.lane); continue; } r -= T_POOL;
        if (r < T_IN) { const int l = r / I_IN, q = r % I_IN, nblk = 2 * DFF / 32, kb = q / nblk, nb = q % nblk; const int n0 = 32 * nb, bj = n0 / DFF, jj = n0 % DFF;
            transpose_item(a.ffn_w_in + (size_t)l * D * 2 * DFF, 2 * DFF, (bf16*)(ws + WS_WIN) + (size_t)l * 2 * DFF * D, D, 256 * (jj / 128) + 128 * bj + (jj % 128), scr, 64 * kb, n0, F.lane); continue; } r -= T_IN;
        { const int l = r / I_OUT, q = r % I_OUT, nblk = D / 32, kb = q / nblk, nb = q % nblk;
            transpose_item(a.ffn_w_out + (size_t)l * DFF * D, D, (bf16*)(ws + WS_WOUT) + (size_t)l * D * DFF, DFF, 32 * nb, scr, 64 * kb, 32 * nb, F.lane); }
    }
}
__device__ __forceinline__ void p_copy_x(Frame F, const Args& a) {
    F.tid = pg8::opaque_v(F.tid); F.lane = F.tid & 63; F.wave = pg8::opaque_s(F.wave); F.vcu = pg8::opaque_s(F.vcu); F.G = pg8::opaque_s(F.G);
    float* X = (float*)(a.ws + WS_X);
    const size_t n4l = (size_t)ML * D / 4, n4c = (size_t)MC * D / 4, stride = (size_t)F.G * 512;
    const f32x4* s0 = (const f32x4*)a.x; const f32x4* s1 = (const f32x4*)a.ctx; f32x4* d = (f32x4*)X;
    for (size_t i = (size_t)F.vcu * 512 + F.tid; i < n4l + n4c; i += stride) d[i] = i < n4l ? s0[i] : s1[i - n4l];
}
__device__ __forceinline__ void p_ada_partial(Frame F, const Args& a) {
    F.tid = pg8::opaque_v(F.tid); F.lane = F.tid & 63; F.wave = pg8::opaque_s(F.wave); F.vcu = pg8::opaque_s(F.vcu); F.G = pg8::opaque_s(F.G);
    LAS float* sc = (LAS float*)(F.lds + RING_OFF);
    float* PART = (float*)(a.ws + WS_PART);
    constexpr int NCC = ADAW / 2048, NITEMS = DEPTH * NCC * KSPLIT;
    for (int it = F.vcu; it < NITEMS; it += F.G) {
        const int kc = it % KSPLIT, cc = (it / KSPLIT) % NCC, l = it / (KSPLIT * NCC);
        __syncthreads();
        if (F.tid < NCOND * 64) { const int i = F.tid >> 6, k = kc * 64 + (F.tid & 63); const float v = i < BATCH ? a.c[i * D + k] : a.c_ctx[k]; sc[F.tid] = silu_f(v); }
        __syncthreads();
        const float* wp = a.ada_w + ((size_t)l * D + kc * 64) * ADAW + cc * 2048 + 4 * F.tid;
        f32x4 acc[NCOND];
#pragma unroll
        for (int i = 0; i < NCOND; ++i) acc[i] = (f32x4){0.f, 0.f, 0.f, 0.f};
#pragma unroll 8
        for (int k = 0; k < 64; ++k) { const f32x4 w = *(const f32x4*)(wp + (size_t)k * ADAW);
#pragma unroll
            for (int i = 0; i < NCOND; ++i) acc[i] += w * sc[i * 64 + k]; }
#pragma unroll
        for (int i = 0; i < NCOND; ++i) *(f32x4*)(PART + (((size_t)kc * DEPTH + l) * NCOND + i) * ADAW + cc * 2048 + 4 * F.tid) = acc[i];
    }
}
__device__ __forceinline__ void p_ada_reduce(Frame F, const Args& a) {
    F.tid = pg8::opaque_v(F.tid); F.lane = F.tid & 63; F.wave = pg8::opaque_s(F.wave); F.vcu = pg8::opaque_s(F.vcu); F.G = pg8::opaque_s(F.G);
    const float* PART = (const float*)(a.ws + WS_PART); float* ADA = (float*)(a.ws + WS_ADA);
    constexpr int N4 = DEPTH * NCOND * ADAW / 4;
    for (int i = F.vcu * 512 + F.tid; i < N4; i += F.G * 512) {
        const int col4 = i % (ADAW / 4), l = i / (NCOND * ADAW / 4);
        f32x4 s = *(const f32x4*)(a.ada_b + (size_t)l * ADAW + 4 * col4);
        for (int kc = 0; kc < KSPLIT; ++kc) s += *(const f32x4*)(PART + (size_t)kc * DEPTH * NCOND * ADAW + 4 * (size_t)i);
        *(f32x4*)(ADA + 4 * (size_t)i) = s;
    }
}
__device__ __forceinline__ void p_modulate(Frame F, const Args& a, int nrows, const float* ada_l, int sh_off, int sc_off) {
    F.tid = pg8::opaque_v(F.tid); F.lane = F.tid & 63; F.wave = pg8::opaque_s(F.wave); F.vcu = pg8::opaque_s(F.vcu); F.G = pg8::opaque_s(F.G);
    const float* X = (const float*)(a.ws + WS_X); bf16* H = (bf16*)(a.ws + WS_H);
    const int gw = F.vcu * NWAVES + F.wave, NGW = F.G * NWAVES;
    for (int r = gw; r < nrows; r += NGW) {
        const int cond = r < ML ? r / SEQ : BATCH; const float* ap = ada_l + (size_t)cond * ADAW;
#pragma unroll
        for (int j = 0; j < 8; ++j) { const int col = 4 * F.lane + 256 * j; const f32x4 v = *(const f32x4*)(X + (size_t)r * D + col), sh = *(const f32x4*)(ap + sh_off + col), sc = *(const f32x4*)(ap + sc_off + col);
            const f32x4 h = v * (sc + 1.0f) + sh; v2u o; o.x = pk2(h[0], h[1]); o.y = pk2(h[2], h[3]); *(v2u*)(H + (size_t)r * D + col) = o; }
    }
}
__device__ __forceinline__ void p_layernorm(Frame F, const Args& a, int nrows, const float* g, const float* b, float* outp, bf16* H, const float* ada_n, int sh_off, int sc_off, const float* part, const float* gate_c) {
    F.tid = pg8::opaque_v(F.tid); F.lane = F.tid & 63; F.wave = pg8::opaque_s(F.wave); F.vcu = pg8::opaque_s(F.vcu); F.G = pg8::opaque_s(F.G);
    const float* X = (const float*)(a.ws + WS_X);
    LAS float* LG = (LAS float*)(F.lds + RING_OFF); LAS float* LB = LG + D; LAS float* LH = LG + 2 * D;
    __syncthreads();
    for (int c = F.tid; c < D; c += NWAVES * 64) { const float gg = g[c], bb = b[c]; LG[c] = gg; LB[c] = bb;
        if (ada_n) {
#pragma unroll
            for (int cd = 0; cd < NCOND; ++cd) { const float sc1 = ada_n[(size_t)cd * ADAW + sc_off + c] + 1.0f, sh = ada_n[(size_t)cd * ADAW + sh_off + c]; LH[(cd * 2 + 0) * D + c] = gg * sc1; LH[(cd * 2 + 1) * D + c] = bb * sc1 + sh; } } }
    __syncthreads();
    const int gw = F.vcu * NWAVES + F.wave, NGW = F.G * NWAVES;
    const int per = ML / NGW;
    const int r_lo = gw * per; int nk = per; int extra = -1;
    if (nrows > ML && (gw & 1) == 0 && (gw >> 1) < MC) { extra = ML + (gw >> 1); ++nk; }
    if (NGW * per == ML) {
    f32x4 nx[8];
#pragma unroll
    for (int j = 0; j < 8; ++j) nx[j] = *(const f32x4*)(X + (size_t)r_lo * D + 4 * F.lane + 256 * j);
    for (int k = 0; k < nk; ++k) {
        const int r = k < per ? r_lo + k : extra;
        f32x4 v[8];
#pragma unroll
        for (int j = 0; j < 8; ++j) v[j] = nx[j];
        if (k + 1 < nk) { const int rn = k + 1 < per ? r_lo + k + 1 : extra;
#pragma unroll
            for (int j = 0; j < 8; ++j) nx[j] = *(const f32x4*)(X + (size_t)rn * D + 4 * F.lane + 256 * j); }
        if (part && r >= ML) { const float* pp = part + (size_t)(r - ML) * D + 4 * F.lane;
#pragma unroll
            for (int j = 0; j < 8; ++j) { const f32x4 ps = (*(const f32x4*)(pp + 256 * j) + *(const f32x4*)(pp + (size_t)MC * D + 256 * j)) + (*(const f32x4*)(pp + (size_t)2 * MC * D + 256 * j) + *(const f32x4*)(pp + (size_t)3 * MC * D + 256 * j));
                v[j] = v[j] * DN_ALPHA + *(const f32x4*)(gate_c + 4 * F.lane + 256 * j) * ps; } }
        float s = 0.f;
#pragma unroll
        for (int j = 0; j < 8; ++j) s += (v[j][0] + v[j][1]) + (v[j][2] + v[j][3]);
        const int cond = r < ML ? r / SEQ : BATCH;
        const float mean = wave_sum(s) * (1.f / D); float s2 = 0.f;
#pragma unroll
        for (int j = 0; j < 8; ++j) { v[j] = v[j] - mean; s2 += (v[j][0] * v[j][0] + v[j][1] * v[j][1]) + (v[j][2] * v[j][2] + v[j][3] * v[j][3]); }
        const float rstd = 1.f / sqrtf(wave_sum(s2) * (1.f / D) + LN_EPS);
        const LAS float* hgp = LH + (size_t)(cond * 2) * D + 4 * F.lane;
#pragma unroll
        for (int j = 0; j < 8; ++j) { const int col = 4 * F.lane + 256 * j; const f32x4 yh = v[j] * rstd;
            *(f32x4*)(outp + (size_t)r * D + col) = yh * *(const LAS f32x4*)(LG + col) + *(const LAS f32x4*)(LB + col);
            if (ada_n) { const f32x4 h = yh * *(const LAS f32x4*)(hgp + 256 * j) + *(const LAS f32x4*)(hgp + D + 256 * j);
                v2u o; o.x = pg8::cvt_pk_bf16(h[0], h[1]); o.y = pg8::cvt_pk_bf16(h[2], h[3]); *(v2u*)(H + (size_t)r * D + col) = o; } }
    } }
    __syncthreads();
}
__device__ __forceinline__ void p_pool(Frame F, const Args& a, int nrows, const float* ada_l) {
    F.tid = pg8::opaque_v(F.tid); F.lane = F.tid & 63; F.wave = pg8::opaque_s(F.wave); F.vcu = pg8::opaque_s(F.vcu); F.G = pg8::opaque_s(F.G);
    const float* X = (const float*)(a.ws + WS_X); bf16* P = (bf16*)(a.ws + WS_O);
    const int gw = F.vcu * NWAVES + F.wave, NGW = F.G * NWAVES;
    constexpr int RUN = 32;
    const int nitems = (nrows / RUN) * 8;
    for (int it = gw; it < nitems; it += NGW) {
        const int cs = it & 7, r0 = (it >> 3) * RUN;
        int base, t0, L, cond;
        if (r0 < ML) { cond = r0 / SEQ; base = cond * SEQ; t0 = r0 - base; L = SEQ; } else { const int q = r0 - ML; cond = BATCH; base = ML + (q / CTXL) * CTXL; t0 = q % CTXL; L = CTXL; }
        const int col = cs * 256 + 4 * F.lane; const int w = 2 << (cs >> 1), hw = w >> 1;
        const f32x4 sc1 = *(const f32x4*)(ada_l + (size_t)cond * ADAW + D + col) + 1.0f;
        const float* xb = X + (size_t)base * D + col;
        int lo = t0 - hw, hi = lo + w; lo = lo < 0 ? 0 : lo; hi = hi > L ? L : hi;
        f32x4 s = (f32x4){0.f, 0.f, 0.f, 0.f};
        for (int tt = lo; tt < hi; ++tt) s += *(const f32x4*)(xb + (size_t)tt * D);
#pragma unroll 4
        for (int i = 0; i < RUN; ++i) { const int t = t0 + i;
            int l2 = t - hw, h2 = l2 + w; const int lo_c = l2 < 0 ? 0 : l2, hi_c = h2 > L ? L : h2;
            const f32x4 xv = *(const f32x4*)(xb + (size_t)t * D);
            const f32x4 p = (s * (1.0f / (float)(hi_c - lo_c)) - xv) * sc1;
            v2u o; o.x = pk2(p[0], p[1]); o.y = pk2(p[2], p[3]); *(v2u*)(P + (size_t)(base + t) * D + col) = o;
            if (h2 < L) s += *(const f32x4*)(xb + (size_t)h2 * D);
            if (l2 >= 0) s -= *(const f32x4*)(xb + (size_t)l2 * D);
        }
    }
}
#define ATT_CHUNK(KEYPTR_EXPR, VALID_EXPR, BIAS_EXPR) do { \
    float s_[4]; v4u kk_[4][4]; \
    _Pragma("unroll") for (int e = 0; e < 4; ++e) { const bf16* kp_ = (KEYPTR_EXPR); _Pragma("unroll") for (int i = 0; i < 4; ++i) kk_[e][i] = *(const v4u*)(kp_ + 8 * i); } \
    _Pragma("unroll") for (int e = 0; e < 4; ++e) { float d_ = 0.f; \
        _Pragma("unroll") for (int i = 0; i < 4; ++i) { const v4u w_ = kk_[e][i]; \
            d_ += qf[8 * i + 0] * bf_lo(w_.x) + qf[8 * i + 1] * bf_hi(w_.x) + qf[8 * i + 2] * bf_lo(w_.y) + qf[8 * i + 3] * bf_hi(w_.y) \
                + qf[8 * i + 4] * bf_lo(w_.z) + qf[8 * i + 5] * bf_hi(w_.z) + qf[8 * i + 6] * bf_lo(w_.w) + qf[8 * i + 7] * bf_hi(w_.w); } \
        d_ += __shfl_xor(d_, 1); d_ += __shfl_xor(d_, 2); \
        s_[e] = (VALID_EXPR) ? d_ + (BIAS_EXPR) : -1e30f; } \
    const float cm_ = fmaxf(fmaxf(s_[0], s_[1]), fmaxf(s_[2], s_[3])); const float mn_ = fmaxf(m, cm_); const float rs_ = __expf(m - mn_); m = mn_; l *= rs_; \
    _Pragma("unroll") for (int i = 0; i < 32; ++i) acc[i] *= rs_; \
    _Pragma("unroll") for (int e = 0; e < 4; ++e) { const float p_ = (s_[e] > -1e29f) ? __expf(s_[e] - m) : 0.f; l += p_; const bf16* vp_ = (KEYPTR_EXPR) + D; \
        _Pragma("unroll") for (int i = 0; i < 4; ++i) { const v4u w_ = *(const v4u*)(vp_ + 8 * i); \
            acc[8 * i + 0] += p_ * bf_lo(w_.x); acc[8 * i + 1] += p_ * bf_hi(w_.x); acc[8 * i + 2] += p_ * bf_lo(w_.y); acc[8 * i + 3] += p_ * bf_hi(w_.y); \
            acc[8 * i + 4] += p_ * bf_lo(w_.z); acc[8 * i + 5] += p_ * bf_hi(w_.z); acc[8 * i + 6] += p_ * bf_lo(w_.w); acc[8 * i + 7] += p_ * bf_hi(w_.w); } } \
} while (0)

__device__ __forceinline__ void p_attention_valu(Frame F, const Args& a, const float* rpb, bool ctx_queries) {
    F.tid = pg8::opaque_v(F.tid); F.lane = F.tid & 63; F.wave = pg8::opaque_s(F.wave); F.vcu = pg8::opaque_s(F.vcu); F.G = pg8::opaque_s(F.G);
    const bf16* QKV = (const bf16*)(a.ws + WS_QKV); bf16* O = (bf16*)(a.ws + WS_O);
    const int gw = F.vcu * NWAVES + F.wave, NGW = F.G * NWAVES;
    const int q = F.lane >> 2, ds = F.lane & 3;
    constexpr int N_LAT = BATCH * 64 * 4 * NH, N_CTX = BATCH * (CTXL / 16) * NH;
    const int ntot = N_LAT + (ctx_queries ? N_CTX : 0);
    for (int u = gw; u < ntot; u += NGW) {
        const bool lat = u < N_LAT; int b, h, qrow, r = 0, j = 0, r0 = 0;
        if (lat) { h = u & 15; int t = u >> 4; j = t & 3; t >>= 2; r = t & 63; b = t >> 6; qrow = b * SEQ + r * GRIDW + j * 16 + q; r0 = r - 4; r0 = r0 < 0 ? 0 : (r0 > 56 ? 56 : r0); }
        else { int t = u - N_LAT; h = t & 15; t >>= 4; const int qb = t & 15; b = t >> 4; qrow = ML + b * CTXL + qb * 16 + q; }
        float qf[32], acc[32];
        { const bf16* qp = QKV + (size_t)qrow * (3 * D) + h * HD + ds * 32;
#pragma unroll
          for (int i = 0; i < 4; ++i) { const v4u w = *(const v4u*)(qp + 8 * i);
              qf[8 * i + 0] = bf_lo(w.x) * ATT_SCALE; qf[8 * i + 1] = bf_hi(w.x) * ATT_SCALE; qf[8 * i + 2] = bf_lo(w.y) * ATT_SCALE; qf[8 * i + 3] = bf_hi(w.y) * ATT_SCALE;
              qf[8 * i + 4] = bf_lo(w.z) * ATT_SCALE; qf[8 * i + 5] = bf_hi(w.z) * ATT_SCALE; qf[8 * i + 6] = bf_lo(w.w) * ATT_SCALE; qf[8 * i + 7] = bf_hi(w.w) * ATT_SCALE; } }
#pragma unroll
        for (int i = 0; i < 32; ++i) acc[i] = 0.f;
        float m = -1e30f, l = 0.f;
        const bf16* kc_base = QKV + (size_t)(ML + b * CTXL) * (3 * D) + D + h * HD + ds * 32;
        for (int k0 = 0; k0 < CTXL; k0 += 4) { ATT_CHUNK(kc_base + (size_t)(k0 + e) * (3 * D), true, 0.f); }
        if (lat) {
            const int qcol = j * 16 + q; int wst = qcol - 8; wst = wst < 0 ? 0 : (wst > 48 ? 48 : wst);
            int bs = j * 16 - 8; bs = bs < 0 ? 0 : (bs > 32 ? 32 : bs);
            const float* rp = rpb + (size_t)h * 15 * 31;
            for (int i = 0; i < 8; ++i) {
                const bf16* krow = QKV + (size_t)(b * SEQ + (r0 + i) * GRIDW + bs) * (3 * D) + D + h * HD + ds * 32;
                const float* rpi = rp + (r0 + i - r + 7) * 31;
                for (int c4 = 0; c4 < 32; c4 += 4) {
#define ATT_KC (bs + c4 + e)
#define ATT_DC (ATT_KC - qcol + 15)
                    ATT_CHUNK(krow + (size_t)(c4 + e) * (3 * D), (ATT_KC >= wst && ATT_KC < wst + 16), rpi[ATT_DC < 0 ? 0 : (ATT_DC > 30 ? 30 : ATT_DC)]);
#undef ATT_KC
#undef ATT_DC
                }
            }
        }
        const float inv = 1.0f / l;
        bf16* op = O + (size_t)qrow * D + h * HD + ds * 32;
#pragma unroll
        for (int i = 0; i < 4; ++i) { v4u w; w.x = pk2(acc[8 * i + 0] * inv, acc[8 * i + 1] * inv); w.y = pk2(acc[8 * i + 2] * inv, acc[8 * i + 3] * inv);
            w.z = pk2(acc[8 * i + 4] * inv, acc[8 * i + 5] * inv); w.w = pk2(acc[8 * i + 6] * inv, acc[8 * i + 7] * inv); *(v4u*)(op + 8 * i) = w; }
    }
}

typedef short att_s4 __attribute__((ext_vector_type(4)));
typedef short att_s8 __attribute__((ext_vector_type(8)));
constexpr int ATT_TAB_OFF = 65536;
__device__ __forceinline__ void p_attention_mfma(Frame F, const Args& a, const float* rpb, bool ctx_queries) {
    F.tid = pg8::opaque_v(F.tid); F.lane = F.tid & 63; F.wave = pg8::opaque_s(F.wave); F.vcu = pg8::opaque_s(F.vcu); F.G = pg8::opaque_s(F.G);
    const bf16* QKV = (const bf16*)(a.ws + WS_QKV); bf16* O = (bf16*)(a.ws + WS_O);
    LAS unsigned char* lds = F.lds + RING_OFF;
    LAS float* tab = (LAS float*)(lds + ATT_TAB_OFF);
    const int tid = F.tid, lane = F.lane, wave = F.wave, i16 = lane & 15, g = lane >> 4;
    constexpr int NU_LAT = BATCH * NH * 32, NU_CTX = BATCH * NH * 2;
    constexpr float L2E = 1.44269504089f, C1 = ATT_SCALE * L2E;
    const int nu = NU_LAT + (ctx_queries ? NU_CTX : 0);
    const int ch = tid & 15, key0 = tid >> 4;
    const int kw = key0 * 256 + ((ch ^ (key0 & 15)) * 16), vw = 16384 + key0 * 256 + (((ch >> 1) ^ (key0 & 7)) * 32) + (ch & 1) * 16;
    for (int u = F.vcu; u < nu; u += F.G) {
        const bool lat = u < NU_LAT;
        int b, h, qrow, r_w = 0, j = 0, kr_lo = 0, nlat = 0;
        if (lat) { const int rp = u & 31; h = (u >> 5) & 15; b = u >> 9; r_w = 2 * rp + (wave >> 2); j = wave & 3; qrow = b * SEQ + r_w * GRIDW + j * 16 + i16;
            int lo = 2 * rp - 4; lo = lo < 0 ? 0 : (lo > 56 ? 56 : lo); int hi = 2 * rp - 3; hi = hi < 0 ? 0 : (hi > 56 ? 56 : hi); kr_lo = lo; nlat = hi + 8 - lo; }
        else { const int t = u - NU_LAT; h = (t >> 1) & 15; b = t >> 5; qrow = ML + b * CTXL + (t & 1) * 128 + wave * 16 + i16; }
        int r0w = r_w - 4; r0w = r0w < 0 ? 0 : (r0w > 56 ? 56 : r0w);
        const int ntiles = nlat + CTXL / 64;
        const size_t hoff = (size_t)h * HD + ch * 8;
        __syncthreads();
        if (lat && tid < 15 * 31) tab[tid] = rpb[(size_t)h * 15 * 31 + tid] * L2E;
        att_s8 qf[4];
        { const bf16* qp = QKV + (size_t)qrow * (3 * D) + h * HD + 8 * g;
#pragma unroll
          for (int st = 0; st < 4; ++st) qf[st] = *(const att_s8*)(qp + 32 * st); }
        f32x4 o[8];
#pragma unroll
        for (int dt = 0; dt < 8; ++dt) o[dt] = (f32x4){0.f, 0.f, 0.f, 0.f};
        float m = -1e30f, lsum = 0.f;
        const int qcol = j * 16 + i16; int wst = qcol - 8; wst = wst < 0 ? 0 : (wst > 48 ? 48 : wst);
        int bs = j * 16 - 8; bs = bs < 0 ? 0 : (bs > 32 ? 32 : bs);
        const int rel = bs + 4 * g - wst, dcb = bs + 4 * g - qcol + 15;
        v4u stg[4];
#define ATT_ROW0(t) ((t) < nlat ? (size_t)(b * SEQ + (kr_lo + (t)) * GRIDW) : (size_t)(ML + b * CTXL + ((t) - nlat) * 64))
#define ATT_LOAD(t) do { const bf16* src_ = QKV + (ATT_ROW0(t) + key0) * (3 * D) + D + hoff; \
            stg[0] = *(const v4u*)src_; stg[1] = *(const v4u*)(src_ + (size_t)32 * 3 * D); stg[2] = *(const v4u*)(src_ + D); stg[3] = *(const v4u*)(src_ + (size_t)32 * 3 * D + D); } while (0)
#define ATT_WRITE(buf) do { LAS unsigned char* d_ = lds + (buf) * 32768; *(LAS v4u*)(d_ + kw) = stg[0]; *(LAS v4u*)(d_ + kw + 8192) = stg[1]; *(LAS v4u*)(d_ + vw) = stg[2]; *(LAS v4u*)(d_ + vw + 8192) = stg[3]; } while (0)
        ATT_LOAD(0); ATT_WRITE(0);
        __syncthreads();
        for (int t = 0; t < ntiles; ++t) {
            if (t + 1 < ntiles) ATT_LOAD(t + 1);
            const bool tl = t < nlat; const int kr = kr_lo + t;
            const bool active = !tl || (kr >= r0w && kr <= r0w + 7);
            if (active) {
                LAS unsigned char* kb = lds + (t & 1) * 32768;
                const int nst = tl ? 1 : 2;
                for (int st = 0; st < nst; ++st) {
                    const int koff = tl ? bs : 32 * st;
                    f32x4 s0 = (f32x4){0.f, 0.f, 0.f, 0.f}, s1 = (f32x4){0.f, 0.f, 0.f, 0.f};
                    { const int key = koff + i16, sw = key & 15; LAS unsigned char* kp = kb + key * 256;
#pragma unroll
                      for (int sp = 0; sp < 4; ++sp) { const int off = ((4 * sp + g) ^ sw) * 16;
                          const att_s8 k0 = *(LAS att_s8*)(kp + off), k1 = *(LAS att_s8*)(kp + 4096 + off);
                          s0 = __builtin_amdgcn_mfma_f32_16x16x32_bf16(k0, qf[sp], s0, 0, 0, 0); s1 = __builtin_amdgcn_mfma_f32_16x16x32_bf16(k1, qf[sp], s1, 0, 0, 0); } }
                    float tv[8]; float tmax = -1e30f;
                    if (tl) { LAS float* tr = tab + (kr - r_w + 7) * 31;
#pragma unroll
                        for (int e = 0; e < 8; ++e) { const int x = (e >> 2) * 16 + (e & 3); const bool valid = (unsigned)(rel + x) < 16u; int dc = dcb + x; dc = dc < 0 ? 0 : (dc > 30 ? 30 : dc);
                            const float sv = (e < 4 ? s0[e & 3] : s1[e & 3]) * C1 + tr[dc]; tv[e] = valid ? sv : -1e30f; tmax = fmaxf(tmax, tv[e]); } }
                    else {
#pragma unroll
                        for (int e = 0; e < 8; ++e) { tv[e] = (e < 4 ? s0[e & 3] : s1[e & 3]) * C1; tmax = fmaxf(tmax, tv[e]); } }
                    tmax = fmaxf(tmax, __shfl_xor(tmax, 16)); tmax = fmaxf(tmax, __shfl_xor(tmax, 32));
                    const float mn = fmaxf(m, tmax);
                    if (!__all(mn == m)) { const float al = __builtin_amdgcn_exp2f(m - mn); lsum *= al;
#pragma unroll
                        for (int dt = 0; dt < 8; ++dt) o[dt] = o[dt] * al; }
                    m = mn;
                    float p[8];
#pragma unroll
                    for (int e = 0; e < 8; ++e) { p[e] = tv[e] > -1e29f ? __builtin_amdgcn_exp2f(tv[e] - m) : 0.f; lsum += p[e]; }
                    union { att_s8 v; unsigned w[4]; } pf;
                    pf.w[0] = pg8::cvt_pk_bf16(p[0], p[1]); pf.w[1] = pg8::cvt_pk_bf16(p[2], p[3]); pf.w[2] = pg8::cvt_pk_bf16(p[4], p[5]); pf.w[3] = pg8::cvt_pk_bf16(p[6], p[7]);
                    { const int swv = 4 * (g & 1) + (i16 >> 2); LAS unsigned char* vp = kb + 16384 + (koff + 4 * g + (i16 >> 2)) * 256 + (i16 & 3) * 8;
#pragma unroll
                      for (int dt = 0; dt < 8; ++dt) { const int off = (dt ^ swv) * 32;
                          const att_s4 va = __builtin_amdgcn_ds_read_tr16_b64_v4i16((LAS att_s4*)(vp + off)), vb = __builtin_amdgcn_ds_read_tr16_b64_v4i16((LAS att_s4*)(vp + 4096 + off));
                          const att_s8 vf = __builtin_shufflevector(va, vb, 0, 1, 2, 3, 4, 5, 6, 7);
                          o[dt] = __builtin_amdgcn_mfma_f32_16x16x32_bf16(vf, pf.v, o[dt], 0, 0, 0); } }
                }
            }
            if (t + 1 < ntiles) ATT_WRITE((t + 1) & 1);
            __syncthreads();
        }
#undef ATT_ROW0
#undef ATT_LOAD
#undef ATT_WRITE
        lsum += __shfl_xor(lsum, 16); lsum += __shfl_xor(lsum, 32);
        const float inv = 1.0f / lsum;
        bf16* op = O + (size_t)qrow * D + h * HD + 4 * g;
#pragma unroll
        for (int dt = 0; dt < 8; ++dt) { v2u w; w.x = pg8::cvt_pk_bf16(o[dt][0] * inv, o[dt][1] * inv); w.y = pg8::cvt_pk_bf16(o[dt][2] * inv, o[dt][3] * inv); *(v2u*)(op + 16 * dt) = w; }
    }
    __syncthreads();
}

constexpr int NPHASE = 3 + 7 * DEPTH;
__global__ void __launch_bounds__(NWAVES * 64, 2) fwd(Args args) {
    extern __shared__ __attribute__((aligned(16))) unsigned char lds[];
    Frame F;
    F.lds = (LAS unsigned char*)lds;
    F.MISC = (volatile LAS unsigned*)(F.lds + MISC_OFF);
    F.tid = threadIdx.x; F.lane = F.tid & 63; F.wave = __builtin_amdgcn_readfirstlane(F.tid >> 6);
    F.G = gridDim.x; { const int bx = blockIdx.x; F.vcu = (F.G % 8 == 0) ? (bx % 8) * (F.G / 8) + bx / 8 : bx; }
    unsigned char* ws = args.ws;
    F.ctl = (gu32*)(ws + WS_CTL);
    for (int u = F.tid; u < (LDS_BYTES - LDSCTL_OFF) / 4; u += NWAVES * 64) ((LAS unsigned*)(F.lds + LDSCTL_OFF))[u] = 0u;
    __syncthreads();
    const int lo = args.ph_lo, hi = args.ph_hi;
    const bool multi = (hi - lo) > 1;
    XcdBarrier bar; bar.bar = (unsigned*)(F.ctl + CW_BAR); bar.x = 0; bar.st = nullptr;
    if (multi) bar = xcd_barrier_post((unsigned*)(F.ctl + CW_BAR), F.MISC + 8);
#define IN(k) (lo <= (k) && (k) < hi)
#define SEAM(k) do { if (IN((k) + 1)) xcd_barrier(bar); } while (0)

    float* const X = (float*)(ws + WS_X);
    const float* const ADA = (const float*)(ws + WS_ADA);
    bf16* const H = (bf16*)(ws + WS_H);

#ifndef PROBE_ID
#define PROBE_ID 0
#endif
#define NREP(id) ((PROBE_ID) == (id) ? 2 : 1)
    float* const XDUM = (float*)(ws + WS_DUMX); bf16* const HDUM = (bf16*)(ws + WS_DUMH);
    if (IN(0)) { for (int rep = 0; rep < NREP(1); ++rep) { p_ada_partial(F, args); __syncthreads(); p_convert_weights(F, args); p_copy_x(F, args); } SEAM(0); }
    if (IN(1)) { p_ada_reduce(F, args); SEAM(1); }
    if (IN(2)) { p_modulate(F, args, MR, ADA, 0, D); SEAM(2); }

    for (int l = 0; l < DEPTH; ++l) {
        const int pb = 3 + 7 * l;
        const bool use_na = (l & 1) == 0; const int j = l >> 1;
        const int rows = l < 2 ? MR : ML;
        const float* ada_l = ADA + (size_t)l * NCOND * ADAW;
        if (use_na) {
            if (IN(pb + 0)) {
                for (int rep = 0; rep < NREP(2); ++rep) {
                pg8::Gemm g{H, (const bf16*)(ws + WS_WQKV) + (size_t)j * 3 * D * D, MR, 3 * D, D, D, D, 0, 0}; pg8::StaticOrder S; S.init(MR, 3 * D, pg8::opaque_s(F.G), pg8::opaque_s((int)blockIdx.x));
                pg8::EpiBf16 E{(bf16*)(ws + WS_QKV), 3 * D};
                pg8::gemm_phase<pg8::EpiBf16, pg8::StaticOrder, true, true>(F.lds + RING_OFF, g, S, E); }
                SEAM(pb + 0);
            }
            if (IN(pb + 1)) { for (int rep = 0; rep < NREP(3); ++rep) p_attention_mfma(F, args, args.na_rpb + (size_t)j * NH * 15 * 31, l == 0); SEAM(pb + 1); }
        } else {
            if (IN(pb + 0)) { for (int rep = 0; rep < NREP(4); ++rep) p_pool(F, args, rows, ada_l); SEAM(pb + 0); }
        }
        float* const PARTC = (float*)(ws + WS_PART);
        const bool ctx_split_mix = (l == 0);
        const bool ctx_split_ffn = (l < 2);
        const float* gate_ctx = ada_l + (size_t)BATCH * ADAW;
        if (IN(pb + 2)) {
            for (int rep = 0; rep < NREP(5); ++rep) {
            const int mrows = use_na ? ML : rows;
            pg8::Gemm g; pg8::EpiRes E{X, rep == NREP(5) - 1 ? X : XDUM, D, ada_l + 2 * D, ADAW, nullptr, DN_ALPHA};
            if (use_na) g = pg8::Gemm{(const bf16*)(ws + WS_O), (const bf16*)(ws + WS_WO) + (size_t)j * D * D, mrows, D, D, D, D, 0, 0};
            else { g = pg8::Gemm{(const bf16*)(ws + WS_O), (const bf16*)(ws + WS_WPOOL) + (size_t)j * D * 512, mrows, D, 512, D, 512, 2, 512}; E.colscale = args.pool_scale + (size_t)j * D; }
            pg8::StaticOrder S; S.init(mrows, D, pg8::opaque_s(F.G), pg8::opaque_s((int)blockIdx.x));
            pg8::gemm_phase<pg8::EpiRes, pg8::StaticOrder, true, true>(F.lds + RING_OFF, g, S, E);
            if (ctx_split_mix) {
                pg8::Gemm gc{(const bf16*)(ws + WS_O), (const bf16*)(ws + WS_WO) + (size_t)j * D * D, MR, D, D / 4, D, D, 0, 0}; pg8::SplitOrder Sc; Sc.init(ML / 256, MC / 256, D / 256, 4, pg8::opaque_s(F.G), pg8::opaque_s((int)blockIdx.x));
                pg8::EpiPart Ec{PARTC, D, ML / 256, (size_t)MC * D};
                pg8::gemm_phase<pg8::EpiPart, pg8::SplitOrder, true, true>(F.lds + RING_OFF, gc, Sc, Ec); } }
            SEAM(pb + 2);
        }
        if (IN(pb + 3)) { for (int rep = 0; rep < NREP(6); ++rep) { const bool fin = rep == NREP(6) - 1;
            p_layernorm(F, args, rows, args.ln_mix_g + (size_t)l * D, args.ln_mix_b + (size_t)l * D, fin ? X : XDUM, fin ? H : HDUM, ada_l, 3 * D, 4 * D, ctx_split_mix ? PARTC : nullptr, gate_ctx + 2 * D); } SEAM(pb + 3); }
        if (IN(pb + 4)) {
            for (int rep = 0; rep < NREP(7); ++rep) {
            pg8::Gemm g{H, (const bf16*)(ws + WS_WIN) + (size_t)l * 2 * DFF * D, rows, 2 * DFF, D, D, D, 0, 0}; pg8::StaticOrder S; S.init(rows, 2 * DFF, pg8::opaque_s(F.G), pg8::opaque_s((int)blockIdx.x));
            pg8::EpiSwiGLU E{(bf16*)(ws + WS_ACT), DFF};
            pg8::gemm_phase<pg8::EpiSwiGLU, pg8::StaticOrder, true, true>(F.lds + RING_OFF, g, S, E); }
            SEAM(pb + 4);
        }
        if (IN(pb + 5)) {
            for (int rep = 0; rep < NREP(8); ++rep) {
            pg8::Gemm g{(const bf16*)(ws + WS_ACT), (const bf16*)(ws + WS_WOUT) + (size_t)l * D * DFF, ML, D, DFF, DFF, DFF, 0, 0}; pg8::StaticOrder S; S.init(ML, D, pg8::opaque_s(F.G), pg8::opaque_s((int)blockIdx.x));
            pg8::EpiRes E{X, rep == NREP(8) - 1 ? X : XDUM, D, ada_l + 5 * D, ADAW, nullptr, DN_ALPHA};
            pg8::gemm_phase<pg8::EpiRes, pg8::StaticOrder, true, true>(F.lds + RING_OFF, g, S, E);
            if (ctx_split_ffn) {
                pg8::Gemm gc{(const bf16*)(ws + WS_ACT), (const bf16*)(ws + WS_WOUT) + (size_t)l * D * DFF, MR, D, DFF / 4, DFF, DFF, 0, 0}; pg8::SplitOrder Sc; Sc.init(ML / 256, MC / 256, D / 256, 4, pg8::opaque_s(F.G), pg8::opaque_s((int)blockIdx.x));
                pg8::EpiPart Ec{PARTC, D, ML / 256, (size_t)MC * D};
                pg8::gemm_phase<pg8::EpiPart, pg8::SplitOrder, true, true>(F.lds + RING_OFF, gc, Sc, Ec); } }
            SEAM(pb + 5);
        }
        if (IN(pb + 6)) {
            const bool last = (l == DEPTH - 1);
            const int nrows = l < 2 ? MR : ML;
            for (int rep = 0; rep < NREP(6); ++rep) { const bool fin = rep == NREP(6) - 1;
            p_layernorm(F, args, nrows, args.ln_ffn_g + (size_t)l * D, args.ln_ffn_b + (size_t)l * D, fin ? (last ? args.out : X) : XDUM, fin ? H : HDUM, last ? nullptr : ada_l + (size_t)NCOND * ADAW, 0, D,
                        ctx_split_ffn ? PARTC : nullptr, gate_ctx + 5 * D); }
            if (!last) SEAM(pb + 6);
        }
    }
#undef IN
#undef SEAM
}

extern "C" void kernel_launch(void* const* d_in, const int* in_sizes, int n_in, void* d_out, int out_size, void* d_ws, size_t ws_size, hipStream_t stream) {
    static int grid = 0;
    if (grid == 0) {
        if (n_in != 17 || out_size != ML * D || ws_size < WS_END) { fprintf(stderr, "kernel_launch: unexpected shapes (n_in %d, out %d, ws %zu); nothing launched\n", n_in, out_size, ws_size); grid = -1; return; }
        int dev = 0, cus = 0, per_cu = 0;
        if (hipGetDevice(&dev) != hipSuccess || hipDeviceGetAttribute(&cus, hipDeviceAttributeMultiprocessorCount, dev) != hipSuccess) { grid = -1; return; }
        if (hipFuncSetAttribute((const void*)fwd, hipFuncAttributeMaxDynamicSharedMemorySize, LDS_BYTES) != hipSuccess) { fprintf(stderr, "kernel_launch: hipFuncSetAttribute failed\n"); grid = -1; return; }
        if (hipOccupancyMaxActiveBlocksPerMultiprocessor(&per_cu, (const void*)fwd, NWAVES * 64, LDS_BYTES) != hipSuccess || per_cu < 1)
            fprintf(stderr, "kernel_launch: note: occupancy query reports %d workgroups per CU\n", per_cu);
        (void)hipGetLastError();
        grid = cus;
    }
    if (grid < 0) return;
    if (hipMemsetAsync((char*)d_ws + WS_CTL, 0, CTL_ZERO_BYTES, stream) != hipSuccess) { fprintf(stderr, "kernel_launch: memset failed\n"); return; }
    Args a{};
    a.x = (const float*)d_in[0]; a.c = (const float*)d_in[1]; a.ctx = (const float*)d_in[2]; a.c_ctx = (const float*)d_in[3]; a.ada_w = (const float*)d_in[4]; a.ada_b = (const float*)d_in[5];
    a.ln_mix_g = (const float*)d_in[6]; a.ln_mix_b = (const float*)d_in[7]; a.ln_ffn_g = (const float*)d_in[8]; a.ln_ffn_b = (const float*)d_in[9];
    a.na_w_qkv = (const float*)d_in[10]; a.na_w_o = (const float*)d_in[11]; a.na_rpb = (const float*)d_in[12]; a.pool_w = (const float*)d_in[13]; a.pool_scale = (const float*)d_in[14];
    a.ffn_w_in = (const float*)d_in[15]; a.ffn_w_out = (const float*)d_in[16];
    a.out = (float*)d_out; a.ws = (unsigned char*)d_ws;
#if MK_ONE_LAUNCH
    a.ph_lo = 0; a.ph_hi = NPHASE;
    hipLaunchKernelGGL(fwd, dim3(grid), dim3(NWAVES * 64), LDS_BYTES, stream, a);
#else
    for (int p = 0; p < NPHASE; ++p) {
        const int l = (p - 3) / 7, s = (p - 3) % 7;
        if (p >= 3 && (l & 1) == 1 && s == 1) continue;
        a.ph_lo = p; a.ph_hi = p + 1;
        hipLaunchKernelGGL(fwd, dim3(grid), dim3(NWAVES * 64), LDS_BYTES, stream, a);
    }
#endif
    const hipError_t le = hipPeekAtLastError();
    if (le != hipSuccess) fprintf(stderr, "kernel_launch: launch failed: %s\n", hipGetErrorName(le));
}
```

```cpp
#include <hip/hip_runtime.h>
#include <cstdio>
#include <cstdint>

#ifndef MK_ONE_LAUNCH
#define MK_ONE_LAUNCH 1
#endif

namespace pg8 {
#define PG8_LAS __attribute__((address_space(3)))
typedef unsigned short bf16_t;
typedef short bf16x8 __attribute__((ext_vector_type(8)));
typedef float f32x4 __attribute__((ext_vector_type(4)));
typedef unsigned u32x4 __attribute__((ext_vector_type(4)));
constexpr int BM = 256, BK = 64, HALF = 128, HTB = HALF * BK * 2  , STAGE_BYTES = 8 * HTB, NXCD = 8, WGM = 8;

__host__ __device__ __forceinline__ int lds_byte(int r, int c) { const int st = (r >> 4) * 2 + (c >> 5), rr = r & 15, cc = c & 31, ob = rr * 64 + cc * 2; return st * 1024 + (ob ^ (((ob >> 9) & 1) << 5)); }
__host__ __device__ __forceinline__ void stage_rc(int b, int& R, int& C) { const int st = b / 1024, sb = b % 1024, swz = sb ^ (((sb >> 9) & 1) << 5); R = (st >> 1) * 16 + swz / 64; C = (st & 1) * 32 + (swz % 64) / 2; }
__host__ __device__ __forceinline__ int perm32(int rho) { const int n = rho >> 4, i = rho & 15; return 8 * (i >> 2) + 4 * n + (i & 3); }

__device__ __forceinline__ int opaque_v(int v) { asm volatile("" : "+v"(v)); return v; }
__device__ __forceinline__ int opaque_s(int v) { asm volatile("" : "+s"(v)); return v; }
struct Unit { int pm, pn, ks; };
struct Gemm { const bf16_t* A; const bf16_t* Bt; int M, N, K, lda, ldb, grp_pn, grp_k; };

struct StaticOrder {
    int nM, nN, nwg, G, c, rowmajor = 0;
    __host__ __device__ void init(int M, int N, int G_, int c_) { nM = M / BM; nN = N / BM; nwg = nM * nN; G = G_; c = c_; }
    __host__ __device__ bool next(int i, Unit& u) const {
        const long L = (long)i * G + c; if (L >= nwg) return false;
        int wgid = (int)L; { const int q = nwg / NXCD, r = nwg % NXCD, xcd = wgid % NXCD, off = wgid / NXCD; wgid = (xcd < r ? xcd * (q + 1) : r * (q + 1) + (xcd - r) * q) + off; }
        const int nig = WGM * nN, gid = wgid / nig, fm = gid * WGM, gsz = (nM - fm) < WGM ? (nM - fm) : WGM;
        const int k = wgid % nig; if (rowmajor) { u.pm = fm + k / nN; u.pn = k % nN; } else { u.pm = fm + (k % gsz); u.pn = k / gsz; } u.ks = 0; return true;
    }
    __device__ __forceinline__ void a_ready(const Unit&) const {}
    __device__ __forceinline__ void done(const Unit&) const {}
};

struct SplitOrder {
    int pm0, nN, nsplit, nunits, G, c;
    __host__ __device__ void init(int pm0_, int nM, int nN_, int nsplit_, int G_, int c_) { pm0 = pm0_; nN = nN_; nsplit = nsplit_; nunits = nM * nN_ * nsplit_; G = G_; c = c_; }
    __host__ __device__ bool next(int i, Unit& u) const { const long L = (long)i * G + c; if (L >= nunits) return false; const int l = (int)L, tile = l / nsplit; u.ks = l % nsplit; u.pn = tile % nN; u.pm = pm0 + tile / nN; return true; }
    __device__ __forceinline__ void a_ready(const Unit&) const {}
    __device__ __forceinline__ void done(const Unit&) const {}
};

__device__ __forceinline__ unsigned cvt_pk_bf16(float lo, float hi) { unsigned r; asm volatile("v_cvt_pk_bf16_f32 %0, %1, %2" : "=v"(r) : "v"(lo), "v"(hi)); return r; }

struct EpiBf16 {
    static constexpr bool PERM = true, AFTER_DRAIN = false;
    bf16_t* O; int ldc;
    __device__ __forceinline__ void operator()(const f32x4 (&acc)[2][2][4][2], const Unit& u, int wr, int wc, int fr, int fq) const {
        const int row0 = u.pm * BM + wr * 64 + fr; const int col0 = u.pn * BM + wc * 32 + 8 * fq;
#pragma unroll
        for (int ai = 0; ai < 2; ++ai)
#pragma unroll
            for (int m = 0; m < 4; ++m) { bf16_t* rowp = O + (size_t)(row0 + ai * HALF + m * 16) * ldc + col0;
#pragma unroll
                for (int bj = 0; bj < 2; ++bj) { const f32x4 v0 = acc[ai][bj][m][0], v1 = acc[ai][bj][m][1];
                    u32x4 w; w.x = cvt_pk_bf16(v0[0], v0[1]); w.y = cvt_pk_bf16(v0[2], v0[3]); w.z = cvt_pk_bf16(v1[0], v1[1]); w.w = cvt_pk_bf16(v1[2], v1[3]);
                    *(u32x4*)(rowp + bj * HALF) = w; } }
    }
};
struct EpiSwiGLU {
    static constexpr bool PERM = true, AFTER_DRAIN = false;
    bf16_t* O; int ldc;
    __device__ __forceinline__ float act(float g, float u) const { return g * u * __builtin_amdgcn_rcpf(1.0f + __builtin_amdgcn_exp2f(g * -1.44269504089f)); }
    __device__ __forceinline__ void operator()(const f32x4 (&acc)[2][2][4][2], const Unit& u, int wr, int wc, int fr, int fq) const {
        const int row0 = u.pm * BM + wr * 64 + fr; const int col0 = u.pn * HALF + wc * 32 + 8 * fq;
#pragma unroll
        for (int ai = 0; ai < 2; ++ai)
#pragma unroll
            for (int m = 0; m < 4; ++m) { bf16_t* rowp = O + (size_t)(row0 + ai * HALF + m * 16) * ldc + col0;
                const f32x4 g0 = acc[ai][0][m][0], g1 = acc[ai][0][m][1], u0 = acc[ai][1][m][0], u1 = acc[ai][1][m][1];
                u32x4 w; w.x = cvt_pk_bf16(act(g0[0], u0[0]), act(g0[1], u0[1])); w.y = cvt_pk_bf16(act(g0[2], u0[2]), act(g0[3], u0[3]));
                w.z = cvt_pk_bf16(act(g1[0], u1[0]), act(g1[1], u1[1])); w.w = cvt_pk_bf16(act(g1[2], u1[2]), act(g1[3], u1[3]));
                *(u32x4*)rowp = w; }
    }
};
struct EpiRes {
    static constexpr bool PERM = false, AFTER_DRAIN = false;
    const float* X; float* Xo; int ldx; const float* gate; int gate_stride; const float* colscale; float alpha;
    __device__ __forceinline__ void operator()(const f32x4 (&acc)[2][2][4][2], const Unit& u, int wr, int wc, int fr, int fq) const {
        const int row0 = u.pm * BM + wr * 64 + fr, col0 = u.pn * BM + wc * 32 + 4 * fq;
        const int cond = u.pm < 64 ? (u.pm >> 4) : 4;
        const float* gp = gate + (size_t)cond * gate_stride + col0;
        f32x4 gv[2][2];
#pragma unroll
        for (int bj = 0; bj < 2; ++bj)
#pragma unroll
            for (int n = 0; n < 2; ++n) { gv[bj][n] = *(const f32x4*)(gp + bj * HALF + n * 16); if (colscale) gv[bj][n] = gv[bj][n] * *(const f32x4*)(colscale + col0 + bj * HALF + n * 16); }
#pragma unroll
        for (int ai = 0; ai < 2; ++ai) {
            f32x4 xv[4][2][2];
#pragma unroll
            for (int m = 0; m < 4; ++m) { const float* rowp = X + (size_t)(row0 + ai * HALF + m * 16) * ldx + col0;
#pragma unroll
                for (int bj = 0; bj < 2; ++bj)
#pragma unroll
                    for (int n = 0; n < 2; ++n) xv[m][bj][n] = *(const f32x4*)(rowp + bj * HALF + n * 16); }
#pragma unroll
            for (int m = 0; m < 4; ++m) { float* rowo = Xo + (size_t)(row0 + ai * HALF + m * 16) * ldx + col0;
#pragma unroll
                for (int bj = 0; bj < 2; ++bj)
#pragma unroll
                    for (int n = 0; n < 2; ++n) *(f32x4*)(rowo + bj * HALF + n * 16) = xv[m][bj][n] * alpha + gv[bj][n] * acc[ai][bj][m][n]; }
            asm volatile("" ::: "memory"); }
    }
};

struct EpiPart {
    static constexpr bool PERM = false, AFTER_DRAIN = false;
    float* P; int ldp, pm_base; size_t slice_stride;
    __device__ __forceinline__ void operator()(const f32x4 (&acc)[2][2][4][2], const Unit& u, int wr, int wc, int fr, int fq) const {
        const int row0 = (u.pm - pm_base) * BM + wr * 64 + fr, col0 = u.pn * BM + wc * 32 + 4 * fq; float* base = P + (size_t)u.ks * slice_stride;
#pragma unroll
        for (int ai = 0; ai < 2; ++ai)
#pragma unroll
            for (int m = 0; m < 4; ++m) { float* rowp = base + (size_t)(row0 + ai * HALF + m * 16) * ldp + col0;
#pragma unroll
                for (int bj = 0; bj < 2; ++bj)
#pragma unroll
                    for (int n = 0; n < 2; ++n) *(f32x4*)(rowp + bj * HALF + n * 16) = acc[ai][bj][m][n]; }
    }
};

template <class Epi, class Sched, bool ALIGN_EPI = false, bool SP2 = false>
__device__ __forceinline__ void gemm_phase(PG8_LAS unsigned char* lds, const Gemm g, const Sched& S, const Epi& E) {
    const int tid = opaque_v(threadIdx.x), wid = __builtin_amdgcn_readfirstlane(tid >> 6), lane = tid & 63, wr = wid >> 2, wc = wid & 3, fr = lane & 15, fq = lane >> 4;
    const int K = g.K, nt = K / BK;
    unsigned voffA[2], voffB[2];
#pragma unroll
    for (int i = 0; i < 2; ++i) { int R, C; stage_rc(tid * 16 + i * 8192, R, C); const int Rb = Epi::PERM ? ((R & ~31) + perm32(R & 31)) : R;
        voffA[i] = (unsigned)(R * g.lda + C) * 2u; voffB[i] = (unsigned)(Rb * g.ldb + C) * 2u; }
    const size_t kstep = (size_t)(BK * 2);
    const size_t hstepA = (size_t)HALF * g.lda * 2, hstepB = (size_t)HALF * g.ldb * 2;
    const size_t tstepA = 2 * hstepA, tstepB = 2 * hstepB;
    const unsigned ldsw = (unsigned)wid * 1024u;
    const int aoff = lds_byte(wr * 64 + fr, fq * 8), boff = lds_byte(wc * 32 + fr, fq * 8);
#define PG8_SA(b, h) (((b) * 2 + (h)) * HTB)
#define PG8_SB(b, h) ((4 + (b) * 2 + (h)) * HTB)
#define PG8_STAGE(bufoff, gbase, voff) do { _Pragma("unroll") for (int _i = 0; _i < 2; ++_i) \
        __builtin_amdgcn_global_load_lds((const unsigned*)((const char*)(gbase) + (voff)[_i]), (PG8_LAS unsigned*)(lds + (bufoff) + ldsw + _i * 8192), 16, 0, 0); } while (0)
#define PG8_LDA(dst, b, h) do { _Pragma("unroll") for (int m = 0; m < 4; ++m) _Pragma("unroll") for (int k = 0; k < 2; ++k) dst[m][k] = *(const PG8_LAS bf16x8*)(lds + PG8_SA(b, h) + aoff + m * 2048 + k * 1024); } while (0)
#define PG8_LDB(dst, b, h) do { _Pragma("unroll") for (int n = 0; n < 2; ++n) _Pragma("unroll") for (int k = 0; k < 2; ++k) dst[n][k] = *(const PG8_LAS bf16x8*)(lds + PG8_SB(b, h) + boff + n * 2048 + k * 1024); } while (0)
#define PG8_MMA(ai, bj, At, Bt) do { __builtin_amdgcn_s_setprio(1); _Pragma("unroll") for (int m = 0; m < 4; ++m) _Pragma("unroll") for (int n = 0; n < 2; ++n) _Pragma("unroll") for (int k = 0; k < 2; ++k) \
        acc[ai][bj][m][n] = __builtin_amdgcn_mfma_f32_16x16x32_bf16(Bt[n][k], At[m][k], acc[ai][bj][m][n], 0, 0, 0); __builtin_amdgcn_s_setprio(0); } while (0)
#define PG8_WAIT_V(n) asm volatile("s_waitcnt vmcnt(" #n ")" ::: "memory")
#define PG8_WAIT_L(n) asm volatile("s_waitcnt lgkmcnt(" #n ")" ::: "memory")
#define PG8_BAR __builtin_amdgcn_s_barrier()
#define PG8_SCHED __builtin_amdgcn_sched_barrier(0)
#define PG8_AOF(u) ((size_t)(u).pm * tstepA + (size_t)(u).ks * (size_t)K * 2 + (g.grp_pn ? (size_t)((u).pn / g.grp_pn) * (size_t)g.grp_k * 2 : (size_t)0))
#define PG8_BOF(u) ((size_t)(u).pn * tstepB + (size_t)(u).ks * (size_t)K * 2)
    Unit cur, nxt; int ui = 0;
    if (!S.next(0, cur)) return;
    f32x4 acc[2][2][4][2];
#pragma unroll
    for (int a = 0; a < 2; ++a)
#pragma unroll
        for (int b = 0; b < 2; ++b)
#pragma unroll
            for (int m = 0; m < 4; ++m)
#pragma unroll
                for (int n = 0; n < 2; ++n) acc[a][b][m][n] = (f32x4){0.f, 0.f, 0.f, 0.f};
    bf16x8 At[4][2], B0[2][2], B1[2][2];
    const char* cA = (const char*)g.A + PG8_AOF(cur); const char* cB = (const char*)g.Bt + PG8_BOF(cur);
    S.a_ready(cur);
    if constexpr (SP2) {
        PG8_STAGE(PG8_SB(0, 0), cB, voffB); PG8_STAGE(PG8_SB(0, 1), cB + hstepB, voffB); PG8_STAGE(PG8_SA(0, 0), cA, voffA); PG8_STAGE(PG8_SA(0, 1), cA + hstepA, voffA);
        if (wr == 1) PG8_BAR;
        PG8_WAIT_V(2); PG8_BAR;
        PG8_STAGE(PG8_SB(1, 0), cB + kstep, voffB); PG8_STAGE(PG8_SA(1, 0), cA + kstep, voffA); PG8_STAGE(PG8_SB(1, 1), cB + hstepB + kstep, voffB);
        PG8_WAIT_V(6); PG8_BAR;
    } else {
        PG8_STAGE(PG8_SB(0, 0), cB, voffB); PG8_STAGE(PG8_SA(0, 0), cA, voffA); PG8_STAGE(PG8_SB(0, 1), cB + hstepB, voffB); PG8_STAGE(PG8_SA(0, 1), cA + hstepA, voffA);
        if (wr == 1) PG8_BAR;
        PG8_WAIT_V(4); PG8_BAR;
        PG8_STAGE(PG8_SB(1, 0), cB + kstep, voffB); PG8_STAGE(PG8_SA(1, 0), cA + kstep, voffA); PG8_STAGE(PG8_SB(1, 1), cB + hstepB + kstep, voffB);
        PG8_WAIT_V(6); PG8_BAR;
    }
    for (;;) {
        const bool has_next = S.next(ui + 1, nxt);
        const char* nA = has_next ? (const char*)g.A + PG8_AOF(nxt) : cA; const char* nB = has_next ? (const char*)g.Bt + PG8_BOF(nxt) : cB;
        for (int t = 0; t < nt; t += 2) {
            const bool last = (t == nt - 2);
            const char* a1 = cA + (size_t)(t + 1) * kstep;
            const char* a2 = last ? nA : cA + (size_t)(t + 2) * kstep; const char* b2 = last ? nB : cB + (size_t)(t + 2) * kstep;
            const char* a3 = a2 + kstep; const char* b3 = b2 + kstep;
            if (last && has_next) S.a_ready(nxt);
            if constexpr (SP2) {
            PG8_LDB(B0, 0, 0); PG8_LDB(B1, 0, 1); PG8_SCHED; PG8_LDA(At, 0, 0); PG8_STAGE(PG8_SA(1, 1), a1 + hstepA, voffA);
            PG8_WAIT_V(8); PG8_WAIT_L(0); PG8_BAR; PG8_MMA(0, 0, At, B0); PG8_MMA(0, 1, At, B1); PG8_BAR; PG8_SCHED;
            PG8_LDA(At, 0, 1); PG8_STAGE(PG8_SB(0, 0), b2, voffB); PG8_STAGE(PG8_SB(0, 1), b2 + hstepB, voffB); PG8_STAGE(PG8_SA(0, 0), a2, voffA);
            PG8_WAIT_V(8); PG8_WAIT_L(0); PG8_BAR; PG8_MMA(1, 0, At, B0); PG8_MMA(1, 1, At, B1); PG8_BAR; PG8_SCHED;
            PG8_LDB(B0, 1, 0); PG8_LDB(B1, 1, 1); PG8_SCHED; PG8_LDA(At, 1, 0); PG8_STAGE(PG8_SA(0, 1), a2 + hstepA, voffA);
            PG8_WAIT_V(8); PG8_WAIT_L(0); PG8_BAR; PG8_MMA(0, 0, At, B0); PG8_MMA(0, 1, At, B1); PG8_BAR; PG8_SCHED;
            PG8_LDA(At, 1, 1); PG8_STAGE(PG8_SB(1, 0), b3, voffB); PG8_STAGE(PG8_SB(1, 1), b3 + hstepB, voffB); PG8_STAGE(PG8_SA(1, 0), a3, voffA);
            PG8_WAIT_V(8); PG8_WAIT_L(0); PG8_BAR; PG8_MMA(1, 0, At, B0); PG8_MMA(1, 1, At, B1); PG8_BAR; PG8_SCHED;
            } else {
            PG8_LDB(B0, 0, 0); PG8_SCHED; PG8_LDA(At, 0, 0); PG8_STAGE(PG8_SA(1, 1), a1 + hstepA, voffA);
            PG8_WAIT_L(8); PG8_BAR; PG8_WAIT_L(0); PG8_MMA(0, 0, At, B0); PG8_BAR; PG8_SCHED;
            PG8_LDB(B1, 0, 1); PG8_STAGE(PG8_SB(0, 0), b2, voffB);
            PG8_BAR; PG8_WAIT_L(0); PG8_MMA(0, 1, At, B1); PG8_BAR;
            PG8_LDA(At, 0, 1); PG8_STAGE(PG8_SA(0, 0), a2, voffA);
            PG8_BAR; PG8_WAIT_L(0); PG8_MMA(1, 0, At, B0); PG8_BAR; PG8_SCHED;
            PG8_STAGE(PG8_SB(0, 1), b2 + hstepB, voffB);
            PG8_WAIT_V(6); PG8_BAR; PG8_MMA(1, 1, At, B1); PG8_BAR;
            PG8_LDB(B0, 1, 0); PG8_SCHED; PG8_LDA(At, 1, 0); PG8_STAGE(PG8_SA(0, 1), a2 + hstepA, voffA);
            PG8_WAIT_L(8); PG8_BAR; PG8_WAIT_L(0); PG8_MMA(0, 0, At, B0); PG8_BAR; PG8_SCHED;
            PG8_LDB(B1, 1, 1); PG8_STAGE(PG8_SB(1, 0), b3, voffB);
            PG8_BAR; PG8_WAIT_L(0); PG8_MMA(0, 1, At, B1); PG8_BAR;
            PG8_LDA(At, 1, 1); PG8_STAGE(PG8_SA(1, 0), a3, voffA);
            PG8_BAR; PG8_WAIT_L(0); PG8_MMA(1, 0, At, B0); PG8_BAR; PG8_SCHED;
            PG8_STAGE(PG8_SB(1, 1), b3 + hstepB, voffB);
            PG8_WAIT_V(6); PG8_BAR; PG8_MMA(1, 1, At, B1); PG8_BAR;
            }
        }
        if constexpr (ALIGN_EPI) { if (wr == 0) PG8_BAR; }
        if constexpr (!Epi::AFTER_DRAIN) { E(acc, cur, wr, wc, fr, fq); S.done(cur); }
        if (!has_next) break;
#pragma unroll
        for (int a = 0; a < 2; ++a)
#pragma unroll
            for (int b = 0; b < 2; ++b)
#pragma unroll
                for (int m = 0; m < 4; ++m)
#pragma unroll
                    for (int n = 0; n < 2; ++n) acc[a][b][m][n] = (f32x4){0.f, 0.f, 0.f, 0.f};
        cur = nxt; cA = nA; cB = nB; ++ui;
        if constexpr (ALIGN_EPI) { if (wr == 1) PG8_BAR; }
    }
    PG8_WAIT_V(0);
    if constexpr (!ALIGN_EPI) { if (wr == 0) PG8_BAR; }
    PG8_BAR;
#undef PG8_AOF
#undef PG8_BOF
#undef PG8_SA
#undef PG8_SB
#undef PG8_STAGE
#undef PG8_LDA
#undef PG8_LDB
#undef PG8_MMA
#undef PG8_WAIT_V
#undef PG8_WAIT_L
#undef PG8_BAR
#undef PG8_SCHED
}
}

constexpr int NWAVES = 8;
constexpr int D = 2048, BATCH = 4, SEQ = 4096, DEPTH = 4, CTXL = 256, GRIDW = 64, NH = 16, HD = 128;
constexpr int DFF = 5632, NADA = 6;
constexpr int ML = BATCH * SEQ;
constexpr int MC = BATCH * CTXL;
constexpr int MR = ML + MC;
constexpr int NCOND = BATCH + 1;
constexpr int ADAW = NADA * D;
constexpr float LN_EPS = 1e-5f;
constexpr float DN_ALPHA = 1.6817928305074290f;
constexpr float ATT_SCALE = 0.08838834764831845f;
constexpr int KSPLIT = 32;

constexpr size_t MiB = 1u << 20;
constexpr size_t WS_CTL = 0, CTL_ZERO_BYTES = 1 * MiB;
constexpr size_t WS_ADA = 1 * MiB;
constexpr size_t WS_PART = 2 * MiB;
constexpr size_t WS_WQKV = 34 * MiB;
constexpr size_t WS_WO = 82 * MiB;
constexpr size_t WS_WPOOL = 98 * MiB;
constexpr size_t WS_WIN = 102 * MiB;
constexpr size_t WS_WOUT = 278 * MiB;
constexpr size_t WS_X = 366 * MiB;
constexpr size_t WS_H = 502 * MiB;
constexpr size_t WS_QKV = 570 * MiB;
constexpr size_t WS_O = 774 * MiB;
constexpr size_t WS_ACT = 842 * MiB;
constexpr size_t WS_DUMX = 1030 * MiB;
constexpr size_t WS_DUMH = 1166 * MiB;
constexpr size_t WS_END = 1234 * MiB;
constexpr int CW_TMO = 0, CW_CODE = 1;
constexpr int CW_BAR = 4096;

constexpr int RING_OFF = 0, RING_BYTES = 131072;
constexpr int LDSCTL_OFF = RING_BYTES, MISC_OFF = LDSCTL_OFF + 320;
constexpr int LDS_BYTES = 147456;

#define GAS __attribute__((address_space(1)))
#define LAS __attribute__((address_space(3)))
typedef unsigned short bf16;
typedef unsigned v4u __attribute__((ext_vector_type(4)));
typedef unsigned v2u __attribute__((ext_vector_type(2)));
typedef float f32x4 __attribute__((ext_vector_type(4)));
typedef GAS unsigned gu32;
#define RLX_AGENT __ATOMIC_RELAXED, __HIP_MEMORY_SCOPE_AGENT
#define LDS_WAIT() asm volatile("s_waitcnt lgkmcnt(0)" ::: "memory")
#define VM_WAIT() asm volatile("s_waitcnt vmcnt(0)" ::: "memory")
__device__ __forceinline__ unsigned f2bf(float f) { unsigned u = __builtin_bit_cast(unsigned, f); return (u + 0x7fffu + ((u >> 16) & 1u)) >> 16; }
__device__ __forceinline__ unsigned pk2(float lo, float hi) { return f2bf(lo) | (f2bf(hi) << 16); }
__device__ __forceinline__ float bf_lo(unsigned w) { return __builtin_bit_cast(float, w << 16); }
__device__ __forceinline__ float bf_hi(unsigned w) { return __builtin_bit_cast(float, w & 0xffff0000u); }

#define XB_TMO      128
#define XB_XCNT(j)  (256  + 64 * (j))
#define XB_XSUB(j)  (1280 + 64 * (j))
#define XB_XGEN(j)  (2304 + 64 * (j))
#define XB_TOP      3328
#define XB_TOPGEN   3392
#define XCD_BAR_WORDS 3456
#define XB_SPIN_CAP (1u << 18)

__device__ __forceinline__ unsigned xb_ld(unsigned* p)              { return __hip_atomic_load(p, __ATOMIC_RELAXED, __HIP_MEMORY_SCOPE_AGENT); }
__device__ __forceinline__ unsigned xb_add(unsigned* p, unsigned v) { return __hip_atomic_fetch_add(p, v, __ATOMIC_RELAXED, __HIP_MEMORY_SCOPE_AGENT); }
__device__ __forceinline__ unsigned xb_xcc_id() { return (unsigned)__builtin_amdgcn_s_getreg((3 << 11) | 20) & 0xFu; }
#define XB_SPIN(cond, bar) do { unsigned _sp = 0; while (cond) { __builtin_amdgcn_s_sleep(1); \
    if ((++_sp & 255u) == 0u) { if (xb_ld(&(bar)[XB_TMO])) break; if (_sp > XB_SPIN_CAP) { atomicAdd(&(bar)[XB_TMO], 1u); break; } } } } while (0)

struct XcdBarrier { unsigned* bar; unsigned x; volatile LAS unsigned* st; };

__device__ __forceinline__ XcdBarrier xcd_barrier_post(unsigned* bar, volatile LAS unsigned* st) {
    XcdBarrier b; b.bar = bar; b.x = xb_xcc_id(); b.st = st;
    if (threadIdx.x == 0) (void)xb_add(&bar[XB_XCNT(b.x)], 1u);
    return b;
}
__device__ __forceinline__ void xcd_barrier_complete(unsigned* bar, unsigned x, unsigned& nloc, unsigned& nx) {
    const unsigned G = gridDim.x * gridDim.y * gridDim.z;
    unsigned sum, cnt, mine, sp = 0u;
    for (;;) {
        sum = 0u; cnt = 0u; mine = 0u;
#pragma unroll
        for (unsigned j = 0; j < 16; ++j) { const unsigned c = xb_ld(&bar[XB_XCNT(j)]); sum += c; cnt += (c > 0u) ? 1u : 0u; mine = (j == x) ? c : mine; }
        if (sum == G) break;
        __builtin_amdgcn_s_sleep(1);
        if ((++sp & 255u) == 0u) { if (xb_ld(&bar[XB_TMO])) break; if (sp > XB_SPIN_CAP) { atomicAdd(&bar[XB_TMO], 1u); break; } }
    }
    nloc = mine > 0u ? mine : 1u; nx = cnt > 0u ? cnt : 1u;
}
__device__ __forceinline__ void xcd_barrier(const XcdBarrier& b) {
    asm volatile("s_waitcnt vmcnt(0)" ::: "memory");
    __syncthreads();
    if (threadIdx.x == 0) {
        unsigned* bar = b.bar;
        __builtin_amdgcn_s_waitcnt(0);
        unsigned nloc = b.st[0], nx = b.st[1];
        if (nloc == 0u) { xcd_barrier_complete(bar, b.x, nloc, nx); b.st[0] = nloc; b.st[1] = nx; }
        const unsigned old = xb_add(&bar[XB_XSUB(b.x)], 1u);
        const unsigned gen = old / nloc;
        if (old + 1u == (gen + 1u) * nloc) {
            __builtin_amdgcn_fence(__ATOMIC_RELEASE, "agent");
            asm volatile("s_waitcnt vmcnt(0)" ::: "memory");
            const unsigned og = xb_add(&bar[XB_TOP], 1u);
            const unsigned tg = og / nx;
            if (og + 1u == (tg + 1u) * nx) xb_add(&bar[XB_TOPGEN], 1u);
            else XB_SPIN(xb_ld(&bar[XB_TOPGEN]) == tg, bar);
            __builtin_amdgcn_fence(__ATOMIC_ACQUIRE, "agent");
            xb_add(&bar[XB_XGEN(b.x)], 1u);
            asm volatile("s_waitcnt vmcnt(0)" ::: "memory");
        } else {
            XB_SPIN(xb_ld(&bar[XB_XGEN(b.x)]) == gen, bar);
            __builtin_amdgcn_fence(__ATOMIC_ACQUIRE, "agent");
            asm volatile("s_waitcnt vmcnt(0)" ::: "memory");
        }
    }
    __syncthreads();
}

struct Args {
    const float *x, *c, *ctx, *c_ctx, *ada_w, *ada_b, *ln_mix_g, *ln_mix_b, *ln_ffn_g, *ln_ffn_b, *na_w_qkv, *na_w_o, *na_rpb, *pool_w, *pool_scale, *ffn_w_in, *ffn_w_out;
    float* out; unsigned char* ws; int ph_lo, ph_hi;
};
struct Frame {
    LAS unsigned char* lds;
    volatile LAS unsigned* MISC;
    gu32* ctl;
    int tid, lane, wave;
    int vcu, G;
};

__device__ __forceinline__ float wave_sum(float v) {
#pragma unroll
    for (int o = 1; o < 64; o <<= 1) v += __shfl_xor(v, o);
    return v;
}
__device__ __forceinline__ float silu_f(float v) { return v / (1.0f + __expf(-v)); }

struct TrItem { const float* W; bf16* WT; int N, ldt; };
__device__ __forceinline__ void tr_load(const TrItem& t, f32x4 (&ld)[8], int lane) {
    const int kk = lane >> 3, n4 = (lane & 7) * 4;
#pragma unroll
    for (int i = 0; i < 8; ++i) ld[i] = *(const f32x4*)(t.W + (size_t)(8 * i + kk) * t.N + n4);
}
__device__ __forceinline__ void tr_store(const TrItem& t, const f32x4 (&ld)[8], LAS float* scr, int lane) {
    const int kk = lane >> 3, n4 = (lane & 7) * 4;
#pragma unroll
    for (int i = 0; i < 8; ++i) { LAS float* d = scr + (8 * i + kk) * 33 + n4; d[0] = ld[i][0]; d[1] = ld[i][1]; d[2] = ld[i][2]; d[3] = ld[i][3]; }
    LDS_WAIT(); asm volatile("" ::: "memory");
    const int c = lane & 7;
#pragma unroll
    for (int j = 0; j < 4; ++j) { const int n = (lane >> 3) + 8 * j; const LAS float* s = scr + (8 * c) * 33 + n;
        v4u o; o.x = pg8::cvt_pk_bf16(s[0 * 33], s[1 * 33]); o.y = pg8::cvt_pk_bf16(s[2 * 33], s[3 * 33]); o.z = pg8::cvt_pk_bf16(s[4 * 33], s[5 * 33]); o.w = pg8::cvt_pk_bf16(s[6 * 33], s[7 * 33]);
        *(GAS v4u*)(t.WT + (size_t)n * t.ldt + 8 * c) = o; }
    LDS_WAIT(); asm volatile("" ::: "memory");
}
__device__ __forceinline__ TrItem tr_decode(const Args& a, int it) {
    unsigned char* ws = a.ws;
    constexpr int I_QKV = (D / 64) * (3 * D / 32), I_O = (D / 64) * (D / 32), I_POOL = (512 / 64) * (512 / 32), I_IN = (D / 64) * (2 * DFF / 32), I_OUT = (DFF / 64) * (D / 32);
    constexpr int T_QKV = 2 * I_QKV, T_O = 2 * I_O, T_POOL = 8 * I_POOL, T_IN = 4 * I_IN;
    const float* W; bf16* WT; int N, ldt, drow0, k0, n0; int r = it;
    if (r < T_QKV) { const int j = r / I_QKV, q = r % I_QKV, nblk = 3 * D / 32; k0 = 64 * (q / nblk); n0 = 32 * (q % nblk); W = a.na_w_qkv + (size_t)j * D * 3 * D; N = 3 * D; WT = (bf16*)(ws + WS_WQKV) + (size_t)j * 3 * D * D; ldt = D; drow0 = n0; }
    else if ((r -= T_QKV) < T_O) { const int j = r / I_O, q = r % I_O, nblk = D / 32; k0 = 64 * (q / nblk); n0 = 32 * (q % nblk); W = a.na_w_o + (size_t)j * D * D; N = D; WT = (bf16*)(ws + WS_WO) + (size_t)j * D * D; ldt = D; drow0 = n0; }
    else if ((r -= T_O) < T_POOL) { const int jg = r / I_POOL, q = r % I_POOL, nblk = 512 / 32; k0 = 64 * (q / nblk); n0 = 32 * (q % nblk);
        W = a.pool_w + (size_t)jg * 512 * 512; N = 512; WT = (bf16*)(ws + WS_WPOOL) + (size_t)(jg >> 2) * D * 512; ldt = 512; drow0 = (jg & 3) * 512 + n0; }
    else if ((r -= T_POOL) < T_IN) { const int l = r / I_IN, q = r % I_IN, nblk = 2 * DFF / 32; k0 = 64 * (q / nblk); n0 = 32 * (q % nblk); const int bj = n0 / DFF, jj = n0 % DFF;
        W = a.ffn_w_in + (size_t)l * D * 2 * DFF; N = 2 * DFF; WT = (bf16*)(ws + WS_WIN) + (size_t)l * 2 * DFF * D; ldt = D; drow0 = 256 * (jj / 128) + 128 * bj + (jj % 128); }
    else { r -= T_IN; const int l = r / I_OUT, q = r % I_OUT, nblk = D / 32; k0 = 64 * (q / nblk); n0 = 32 * (q % nblk); W = a.ffn_w_out + (size_t)l * DFF * D; N = D; WT = (bf16*)(ws + WS_WOUT) + (size_t)l * D * DFF; ldt = DFF; drow0 = n0; }
    TrItem t; t.W = W + (size_t)k0 * N + n0; t.WT = WT + (size_t)drow0 * ldt + k0; t.N = N; t.ldt = ldt; return t;
}
__device__ __forceinline__ void p_convert_weights(Frame F, const Args& a) {
    F.tid = pg8::opaque_v(F.tid); F.lane = F.tid & 63; F.wave = pg8::opaque_s(F.wave); F.vcu = pg8::opaque_s(F.vcu); F.G = pg8::opaque_s(F.G);
    LAS float* scr = (LAS float*)(F.lds + RING_OFF + F.wave * 16384);
    const int gw = F.vcu * NWAVES + F.wave, NGW = F.G * NWAVES;
    constexpr int NITEMS = 2 * (D / 64) * (3 * D / 32) + 2 * (D / 64) * (D / 32) + 8 * (512 / 64) * (512 / 32) + 4 * (D / 64) * (2 * DFF / 32) + 4 * (DFF / 64) * (D / 32);
    if (gw >= NITEMS) return;
    TrItem cur = tr_decode(a, gw); f32x4 lc[8], ln[8]; tr_load(cur, lc, F.lane);
    for (int it = gw; it < NITEMS; it += NGW) {
        const bool more = it + NGW < NITEMS; TrItem nxt = cur;
        if (more) { nxt = tr_decode(a, it + NGW); tr_load(nxt, ln, F.lane); }
        tr_store(cur, lc, scr, F.lane);
        cur = nxt;
#pragma unroll
        for (int i = 0; i < 8; ++i) lc[i] = ln[i];
    }
}
__device__ __forceinline__ void p_copy_x(Frame F, const Args& a) {
    F.tid = pg8::opaque_v(F.tid); F.lane = F.tid & 63; F.wave = pg8::opaque_s(F.wave); F.vcu = pg8::opaque_s(F.vcu); F.G = pg8::opaque_s(F.G);
    float* X = (float*)(a.ws + WS_X);
    const size_t n4l = (size_t)ML * D / 4, n4c = (size_t)MC * D / 4, stride = (size_t)F.G * 512;
    const f32x4* s0 = (const f32x4*)a.x; const f32x4* s1 = (const f32x4*)a.ctx; f32x4* d = (f32x4*)X;
    for (size_t i = (size_t)F.vcu * 512 + F.tid; i < n4l + n4c; i += stride) d[i] = i < n4l ? s0[i] : s1[i - n4l];
}
__device__ __forceinline__ void p_ada_partial(Frame F, const Args& a) {
    F.tid = pg8::opaque_v(F.tid); F.lane = F.tid & 63; F.wave = pg8::opaque_s(F.wave); F.vcu = pg8::opaque_s(F.vcu); F.G = pg8::opaque_s(F.G);
    LAS float* sc = (LAS float*)(F.lds + RING_OFF);
    float* PART = (float*)(a.ws + WS_PART);
    constexpr int NCC = ADAW / 2048, NITEMS = DEPTH * NCC * KSPLIT;
    for (int it = F.vcu; it < NITEMS; it += F.G) {
        const int kc = it % KSPLIT, cc = (it / KSPLIT) % NCC, l = it / (KSPLIT * NCC);
        __syncthreads();
        if (F.tid < NCOND * 64) { const int i = F.tid >> 6, k = kc * 64 + (F.tid & 63); const float v = i < BATCH ? a.c[i * D + k] : a.c_ctx[k]; sc[F.tid] = silu_f(v); }
        __syncthreads();
        const float* wp = a.ada_w + ((size_t)l * D + kc * 64) * ADAW + cc * 2048 + 4 * F.tid;
        f32x4 acc[NCOND];
#pragma unroll
        for (int i = 0; i < NCOND; ++i) acc[i] = (f32x4){0.f, 0.f, 0.f, 0.f};
#pragma unroll 8
        for (int k = 0; k < 64; ++k) { const f32x4 w = *(const f32x4*)(wp + (size_t)k * ADAW);
#pragma unroll
            for (int i = 0; i < NCOND; ++i) acc[i] += w * sc[i * 64 + k]; }
#pragma unroll
        for (int i = 0; i < NCOND; ++i) *(f32x4*)(PART + (((size_t)kc * DEPTH + l) * NCOND + i) * ADAW + cc * 2048 + 4 * F.tid) = acc[i];
    }
}
__device__ __forceinline__ void p_ada_reduce(Frame F, const Args& a) {
    F.tid = pg8::opaque_v(F.tid); F.lane = F.tid & 63; F.wave = pg8::opaque_s(F.wave); F.vcu = pg8::opaque_s(F.vcu); F.G = pg8::opaque_s(F.G);
    const float* PART = (const float*)(a.ws + WS_PART); float* ADA = (float*)(a.ws + WS_ADA);
    constexpr int N4 = DEPTH * NCOND * ADAW / 4;
    for (int i = F.vcu * 512 + F.tid; i < N4; i += F.G * 512) {
        const int col4 = i % (ADAW / 4), l = i / (NCOND * ADAW / 4);
        f32x4 s = *(const f32x4*)(a.ada_b + (size_t)l * ADAW + 4 * col4);
        for (int kc = 0; kc < KSPLIT; ++kc) s += *(const f32x4*)(PART + (size_t)kc * DEPTH * NCOND * ADAW + 4 * (size_t)i);
        *(f32x4*)(ADA + 4 * (size_t)i) = s;
    }
}
__device__ __forceinline__ void p_modulate(Frame F, const Args& a, int nrows, const float* ada_l, int sh_off, int sc_off) {
    F.tid = pg8::opaque_v(F.tid); F.lane = F.tid & 63; F.wave = pg8::opaque_s(F.wave); F.vcu = pg8::opaque_s(F.vcu); F.G = pg8::opaque_s(F.G);
    bf16* H = (bf16*)(a.ws + WS_H);
    const int gw = F.vcu * NWAVES + F.wave, NGW = F.G * NWAVES;
    for (int r = gw; r < nrows; r += NGW) {
        const int cond = r < ML ? r / SEQ : BATCH; const float* ap = ada_l + (size_t)cond * ADAW; const float* xr = r < ML ? a.x + (size_t)r * D : a.ctx + (size_t)(r - ML) * D;
#pragma unroll
        for (int j = 0; j < 8; ++j) { const int col = 4 * F.lane + 256 * j; const f32x4 v = *(const f32x4*)(xr + col), sh = *(const f32x4*)(ap + sh_off + col), sc = *(const f32x4*)(ap + sc_off + col);
            const f32x4 h = v * (sc + 1.0f) + sh; v2u o; o.x = pk2(h[0], h[1]); o.y = pk2(h[2], h[3]); *(v2u*)(H + (size_t)r * D + col) = o; }
    }
}
__device__ __forceinline__ void p_layernorm(Frame F, const Args& a, int nrows, const float* g, const float* b, float* outp, bf16* H, const float* ada_n, int sh_off, int sc_off, const float* part, const float* gate_c, const float* xc_in) {
    F.tid = pg8::opaque_v(F.tid); F.lane = F.tid & 63; F.wave = pg8::opaque_s(F.wave); F.vcu = pg8::opaque_s(F.vcu); F.G = pg8::opaque_s(F.G);
    const float* X = (const float*)(a.ws + WS_X);
    const float* XC = xc_in ? xc_in - (size_t)ML * D : X;
    LAS float* LG = (LAS float*)(F.lds + RING_OFF); LAS float* LB = LG + D; LAS float* LH = LG + 2 * D;
    __syncthreads();
    for (int c = F.tid; c < D; c += NWAVES * 64) { const float gg = g[c], bb = b[c]; LG[c] = gg; LB[c] = bb;
        if (ada_n) {
#pragma unroll
            for (int cd = 0; cd < NCOND; ++cd) { const float sc1 = ada_n[(size_t)cd * ADAW + sc_off + c] + 1.0f, sh = ada_n[(size_t)cd * ADAW + sh_off + c]; LH[(cd * 2 + 0) * D + c] = gg * sc1; LH[(cd * 2 + 1) * D + c] = bb * sc1 + sh; } } }
    __syncthreads();
    const int gw = F.vcu * NWAVES + F.wave, NGW = F.G * NWAVES;
    const int per = ML / NGW;
    const int r_lo = gw * per; int nk = per; int extra = -1;
    if (nrows > ML && (gw & 1) == 0 && (gw >> 1) < MC) { extra = ML + (gw >> 1); ++nk; }
    if (NGW * per == ML) {
    f32x4 nx[8];
#pragma unroll
    for (int j = 0; j < 8; ++j) nx[j] = *(const f32x4*)(X + (size_t)r_lo * D + 4 * F.lane + 256 * j);
    for (int k = 0; k < nk; ++k) {
        const int r = k < per ? r_lo + k : extra;
        f32x4 v[8];
#pragma unroll
        for (int j = 0; j < 8; ++j) v[j] = nx[j];
        if (k + 1 < nk) { const int rn = k + 1 < per ? r_lo + k + 1 : extra;
#pragma unroll
            for (int j = 0; j < 8; ++j) nx[j] = *(const f32x4*)((rn >= ML ? XC : X) + (size_t)rn * D + 4 * F.lane + 256 * j); }
        if (part && r >= ML) { const float* pp = part + (size_t)(r - ML) * D + 4 * F.lane;
#pragma unroll
            for (int j = 0; j < 8; ++j) { const f32x4 ps = (*(const f32x4*)(pp + 256 * j) + *(const f32x4*)(pp + (size_t)MC * D + 256 * j)) + (*(const f32x4*)(pp + (size_t)2 * MC * D + 256 * j) + *(const f32x4*)(pp + (size_t)3 * MC * D + 256 * j));
                v[j] = v[j] * DN_ALPHA + *(const f32x4*)(gate_c + 4 * F.lane + 256 * j) * ps; } }
        float s = 0.f;
#pragma unroll
        for (int j = 0; j < 8; ++j) s += (v[j][0] + v[j][1]) + (v[j][2] + v[j][3]);
        const int cond = r < ML ? r / SEQ : BATCH;
        const float mean = wave_sum(s) * (1.f / D); float s2 = 0.f;
#pragma unroll
        for (int j = 0; j < 8; ++j) { v[j] = v[j] - mean; s2 += (v[j][0] * v[j][0] + v[j][1] * v[j][1]) + (v[j][2] * v[j][2] + v[j][3] * v[j][3]); }
        const float rstd = 1.f / sqrtf(wave_sum(s2) * (1.f / D) + LN_EPS);
        const LAS float* hgp = LH + (size_t)(cond * 2) * D + 4 * F.lane;
#pragma unroll
        for (int j = 0; j < 8; ++j) { const int col = 4 * F.lane + 256 * j; const f32x4 yh = v[j] * rstd;
            *(f32x4*)(outp + (size_t)r * D + col) = yh * *(const LAS f32x4*)(LG + col) + *(const LAS f32x4*)(LB + col);
            if (ada_n) { const f32x4 h = yh * *(const LAS f32x4*)(hgp + 256 * j) + *(const LAS f32x4*)(hgp + D + 256 * j);
                v2u o; o.x = pg8::cvt_pk_bf16(h[0], h[1]); o.y = pg8::cvt_pk_bf16(h[2], h[3]); *(v2u*)(H + (size_t)r * D + col) = o; } }
    } }
    __syncthreads();
}
__device__ __forceinline__ void p_pool(Frame F, const Args& a, int nrows, const float* ada_l) {
    F.tid = pg8::opaque_v(F.tid); F.lane = F.tid & 63; F.wave = pg8::opaque_s(F.wave); F.vcu = pg8::opaque_s(F.vcu); F.G = pg8::opaque_s(F.G);
    const float* X = (const float*)(a.ws + WS_X); bf16* P = (bf16*)(a.ws + WS_O);
    const int gw = F.vcu * NWAVES + F.wave, NGW = F.G * NWAVES;
    constexpr int RUN = 32;
    const int nitems = (nrows / RUN) * 8;
    for (int it = gw; it < nitems; it += NGW) {
        const int cs = it & 7, r0 = (it >> 3) * RUN;
        int base, t0, L, cond;
        if (r0 < ML) { cond = r0 / SEQ; base = cond * SEQ; t0 = r0 - base; L = SEQ; } else { const int q = r0 - ML; cond = BATCH; base = ML + (q / CTXL) * CTXL; t0 = q % CTXL; L = CTXL; }
        const int col = cs * 256 + 4 * F.lane; const int w = 2 << (cs >> 1), hw = w >> 1;
        const f32x4 sc1 = *(const f32x4*)(ada_l + (size_t)cond * ADAW + D + col) + 1.0f;
        const float* xb = X + (size_t)base * D + col;
        int lo = t0 - hw, hi = lo + w; lo = lo < 0 ? 0 : lo; hi = hi > L ? L : hi;
        f32x4 s = (f32x4){0.f, 0.f, 0.f, 0.f};
        for (int tt = lo; tt < hi; ++tt) s += *(const f32x4*)(xb + (size_t)tt * D);
#pragma unroll 4
        for (int i = 0; i < RUN; ++i) { const int t = t0 + i;
            int l2 = t - hw, h2 = l2 + w; const int lo_c = l2 < 0 ? 0 : l2, hi_c = h2 > L ? L : h2;
            const f32x4 xv = *(const f32x4*)(xb + (size_t)t * D);
            const f32x4 p = (s * (1.0f / (float)(hi_c - lo_c)) - xv) * sc1;
            v2u o; o.x = pk2(p[0], p[1]); o.y = pk2(p[2], p[3]); *(v2u*)(P + (size_t)(base + t) * D + col) = o;
            if (h2 < L) s += *(const f32x4*)(xb + (size_t)h2 * D);
            if (l2 >= 0) s -= *(const f32x4*)(xb + (size_t)l2 * D);
        }
    }
}
#define ATT_CHUNK(KEYPTR_EXPR, VALID_EXPR, BIAS_EXPR) do { \
    float s_[4]; v4u kk_[4][4]; \
    _Pragma("unroll") for (int e = 0; e < 4; ++e) { const bf16* kp_ = (KEYPTR_EXPR); _Pragma("unroll") for (int i = 0; i < 4; ++i) kk_[e][i] = *(const v4u*)(kp_ + 8 * i); } \
    _Pragma("unroll") for (int e = 0; e < 4; ++e) { float d_ = 0.f; \
        _Pragma("unroll") for (int i = 0; i < 4; ++i) { const v4u w_ = kk_[e][i]; \
            d_ += qf[8 * i + 0] * bf_lo(w_.x) + qf[8 * i + 1] * bf_hi(w_.x) + qf[8 * i + 2] * bf_lo(w_.y) + qf[8 * i + 3] * bf_hi(w_.y) \
                + qf[8 * i + 4] * bf_lo(w_.z) + qf[8 * i + 5] * bf_hi(w_.z) + qf[8 * i + 6] * bf_lo(w_.w) + qf[8 * i + 7] * bf_hi(w_.w); } \
        d_ += __shfl_xor(d_, 1); d_ += __shfl_xor(d_, 2); \
        s_[e] = (VALID_EXPR) ? d_ + (BIAS_EXPR) : -1e30f; } \
    const float cm_ = fmaxf(fmaxf(s_[0], s_[1]), fmaxf(s_[2], s_[3])); const float mn_ = fmaxf(m, cm_); const float rs_ = __expf(m - mn_); m = mn_; l *= rs_; \
    _Pragma("unroll") for (int i = 0; i < 32; ++i) acc[i] *= rs_; \
    _Pragma("unroll") for (int e = 0; e < 4; ++e) { const float p_ = (s_[e] > -1e29f) ? __expf(s_[e] - m) : 0.f; l += p_; const bf16* vp_ = (KEYPTR_EXPR) + D; \
        _Pragma("unroll") for (int i = 0; i < 4; ++i) { const v4u w_ = *(const v4u*)(vp_ + 8 * i); \
            acc[8 * i + 0] += p_ * bf_lo(w_.x); acc[8 * i + 1] += p_ * bf_hi(w_.x); acc[8 * i + 2] += p_ * bf_lo(w_.y); acc[8 * i + 3] += p_ * bf_hi(w_.y); \
            acc[8 * i + 4] += p_ * bf_lo(w_.z); acc[8 * i + 5] += p_ * bf_hi(w_.z); acc[8 * i + 6] += p_ * bf_lo(w_.w); acc[8 * i + 7] += p_ * bf_hi(w_.w); } } \
} while (0)

__device__ __forceinline__ void p_attention_valu(Frame F, const Args& a, const float* rpb, bool ctx_queries) {
    F.tid = pg8::opaque_v(F.tid); F.lane = F.tid & 63; F.wave = pg8::opaque_s(F.wave); F.vcu = pg8::opaque_s(F.vcu); F.G = pg8::opaque_s(F.G);
    const bf16* QKV = (const bf16*)(a.ws + WS_QKV); bf16* O = (bf16*)(a.ws + WS_O);
    const int gw = F.vcu * NWAVES + F.wave, NGW = F.G * NWAVES;
    const int q = F.lane >> 2, ds = F.lane & 3;
    constexpr int N_LAT = BATCH * 64 * 4 * NH, N_CTX = BATCH * (CTXL / 16) * NH;
    const int ntot = N_LAT + (ctx_queries ? N_CTX : 0);
    for (int u = gw; u < ntot; u += NGW) {
        const bool lat = u < N_LAT; int b, h, qrow, r = 0, j = 0, r0 = 0;
        if (lat) { h = u & 15; int t = u >> 4; j = t & 3; t >>= 2; r = t & 63; b = t >> 6; qrow = b * SEQ + r * GRIDW + j * 16 + q; r0 = r - 4; r0 = r0 < 0 ? 0 : (r0 > 56 ? 56 : r0); }
        else { int t = u - N_LAT; h = t & 15; t >>= 4; const int qb = t & 15; b = t >> 4; qrow = ML + b * CTXL + qb * 16 + q; }
        float qf[32], acc[32];
        { const bf16* qp = QKV + (size_t)qrow * (3 * D) + h * HD + ds * 32;
#pragma unroll
          for (int i = 0; i < 4; ++i) { const v4u w = *(const v4u*)(qp + 8 * i);
              qf[8 * i + 0] = bf_lo(w.x) * ATT_SCALE; qf[8 * i + 1] = bf_hi(w.x) * ATT_SCALE; qf[8 * i + 2] = bf_lo(w.y) * ATT_SCALE; qf[8 * i + 3] = bf_hi(w.y) * ATT_SCALE;
              qf[8 * i + 4] = bf_lo(w.z) * ATT_SCALE; qf[8 * i + 5] = bf_hi(w.z) * ATT_SCALE; qf[8 * i + 6] = bf_lo(w.w) * ATT_SCALE; qf[8 * i + 7] = bf_hi(w.w) * ATT_SCALE; } }
#pragma unroll
        for (int i = 0; i < 32; ++i) acc[i] = 0.f;
        float m = -1e30f, l = 0.f;
        const bf16* kc_base = QKV + (size_t)(ML + b * CTXL) * (3 * D) + D + h * HD + ds * 32;
        for (int k0 = 0; k0 < CTXL; k0 += 4) { ATT_CHUNK(kc_base + (size_t)(k0 + e) * (3 * D), true, 0.f); }
        if (lat) {
            const int qcol = j * 16 + q; int wst = qcol - 8; wst = wst < 0 ? 0 : (wst > 48 ? 48 : wst);
            int bs = j * 16 - 8; bs = bs < 0 ? 0 : (bs > 32 ? 32 : bs);
            const float* rp = rpb + (size_t)h * 15 * 31;
            for (int i = 0; i < 8; ++i) {
                const bf16* krow = QKV + (size_t)(b * SEQ + (r0 + i) * GRIDW + bs) * (3 * D) + D + h * HD + ds * 32;
                const float* rpi = rp + (r0 + i - r + 7) * 31;
                for (int c4 = 0; c4 < 32; c4 += 4) {
#define ATT_KC (bs + c4 + e)
#define ATT_DC (ATT_KC - qcol + 15)
                    ATT_CHUNK(krow + (size_t)(c4 + e) * (3 * D), (ATT_KC >= wst && ATT_KC < wst + 16), rpi[ATT_DC < 0 ? 0 : (ATT_DC > 30 ? 30 : ATT_DC)]);
#undef ATT_KC
#undef ATT_DC
                }
            }
        }
        const float inv = 1.0f / l;
        bf16* op = O + (size_t)qrow * D + h * HD + ds * 32;
#pragma unroll
        for (int i = 0; i < 4; ++i) { v4u w; w.x = pk2(acc[8 * i + 0] * inv, acc[8 * i + 1] * inv); w.y = pk2(acc[8 * i + 2] * inv, acc[8 * i + 3] * inv);
            w.z = pk2(acc[8 * i + 4] * inv, acc[8 * i + 5] * inv); w.w = pk2(acc[8 * i + 6] * inv, acc[8 * i + 7] * inv); *(v4u*)(op + 8 * i) = w; }
    }
}

typedef short att_s4 __attribute__((ext_vector_type(4)));
typedef short att_s8 __attribute__((ext_vector_type(8)));
constexpr int ATT_TAB_OFF = 65536;
__device__ __forceinline__ void p_attention_mfma(Frame F, const Args& a, const float* rpb, bool ctx_queries) {
    F.tid = pg8::opaque_v(F.tid); F.lane = F.tid & 63; F.wave = pg8::opaque_s(F.wave); F.vcu = pg8::opaque_s(F.vcu); F.G = pg8::opaque_s(F.G);
    const bf16* QKV = (const bf16*)(a.ws + WS_QKV); bf16* O = (bf16*)(a.ws + WS_O);
    LAS unsigned char* lds = F.lds + RING_OFF;
    LAS float* tab = (LAS float*)(lds + ATT_TAB_OFF);
    const int tid = F.tid, lane = F.lane, wave = F.wave, i16 = lane & 15, g = lane >> 4;
    constexpr int NU_LAT = BATCH * NH * 32, NU_CTX = BATCH * NH * 2;
    constexpr float L2E = 1.44269504089f, C1 = ATT_SCALE * L2E;
    const int nu = NU_LAT + (ctx_queries ? NU_CTX : 0);
    const int ch = tid & 15, key0 = tid >> 4;
    const int kw = key0 * 256 + ((ch ^ (key0 & 15)) * 16), vw = 16384 + key0 * 256 + (((ch >> 1) ^ (key0 & 7)) * 32) + (ch & 1) * 16;
    for (int u = F.vcu; u < nu; u += F.G) {
        const bool lat = u < NU_LAT;
        int b, h, qrow, r_w = 0, j = 0, kr_lo = 0, nlat = 0;
        if (lat) { const int rp = u & 31; h = (u >> 5) & 15; b = u >> 9; r_w = 2 * rp + (wave >> 2); j = wave & 3; qrow = b * SEQ + r_w * GRIDW + j * 16 + i16;
            int lo = 2 * rp - 4; lo = lo < 0 ? 0 : (lo > 56 ? 56 : lo); int hi = 2 * rp - 3; hi = hi < 0 ? 0 : (hi > 56 ? 56 : hi); kr_lo = lo; nlat = hi + 8 - lo; }
        else { const int t = u - NU_LAT; h = (t >> 1) & 15; b = t >> 5; qrow = ML + b * CTXL + (t & 1) * 128 + wave * 16 + i16; }
        int r0w = r_w - 4; r0w = r0w < 0 ? 0 : (r0w > 56 ? 56 : r0w);
        const int ntiles = nlat + CTXL / 64;
        const size_t hoff = (size_t)h * HD + ch * 8;
        __syncthreads();
        if (lat && tid < 15 * 31) tab[tid] = rpb[(size_t)h * 15 * 31 + tid] * L2E;
        att_s8 qf[4];
        { const bf16* qp = QKV + (size_t)qrow * (3 * D) + h * HD + 8 * g;
#pragma unroll
          for (int st = 0; st < 4; ++st) qf[st] = *(const att_s8*)(qp + 32 * st); }
        f32x4 o[8];
#pragma unroll
        for (int dt = 0; dt < 8; ++dt) o[dt] = (f32x4){0.f, 0.f, 0.f, 0.f};
        float m = -1e30f, lsum = 0.f;
        const int qcol = j * 16 + i16; int wst = qcol - 8; wst = wst < 0 ? 0 : (wst > 48 ? 48 : wst);
        int bs = j * 16 - 8; bs = bs < 0 ? 0 : (bs > 32 ? 32 : bs);
        const int rel = bs + 4 * g - wst, dcb = bs + 4 * g - qcol + 15;
        v4u stgA[4], stgB[4], stgC[4];
#define ATT_ROW0(t) ((t) < nlat ? (size_t)(b * SEQ + (kr_lo + (t)) * GRIDW) : (size_t)(ML + b * CTXL + ((t) - nlat) * 64))
#define ATT_LOAD(t, stg) do { const bf16* src_ = QKV + (ATT_ROW0(t) + key0) * (3 * D) + D + hoff; \
            stg[0] = *(const v4u*)src_; stg[1] = *(const v4u*)(src_ + (size_t)32 * 3 * D); stg[2] = *(const v4u*)(src_ + D); stg[3] = *(const v4u*)(src_ + (size_t)32 * 3 * D + D); } while (0)
#define ATT_WRITE(buf, stg) do { LAS unsigned char* d_ = lds + (buf) * 32768; *(LAS v4u*)(d_ + kw) = stg[0]; *(LAS v4u*)(d_ + kw + 8192) = stg[1]; *(LAS v4u*)(d_ + vw) = stg[2]; *(LAS v4u*)(d_ + vw + 8192) = stg[3]; } while (0)
#define ATT_COMPUTE(t) do { \
            const bool tl = (t) < nlat; const int kr = kr_lo + (t); \
            const bool active = !tl || (kr >= r0w && kr <= r0w + 7); \
            if (active) { \
                LAS unsigned char* kb = lds + ((t) & 1) * 32768; \
                const int nst = tl ? 1 : 2; \
                for (int st = 0; st < nst; ++st) { \
                    const int koff = tl ? bs : 32 * st; \
                    f32x4 s0 = (f32x4){0.f, 0.f, 0.f, 0.f}, s1 = (f32x4){0.f, 0.f, 0.f, 0.f}; \
                    { const int key = koff + i16, sw = key & 15; LAS unsigned char* kp = kb + key * 256; \
                      _Pragma("unroll") for (int sp = 0; sp < 4; ++sp) { const int off = ((4 * sp + g) ^ sw) * 16; \
                          const att_s8 k0 = *(LAS att_s8*)(kp + off), k1 = *(LAS att_s8*)(kp + 4096 + off); \
                          s0 = __builtin_amdgcn_mfma_f32_16x16x32_bf16(k0, qf[sp], s0, 0, 0, 0); s1 = __builtin_amdgcn_mfma_f32_16x16x32_bf16(k1, qf[sp], s1, 0, 0, 0); } } \
                    float tv[8]; float tmax = -1e30f; \
                    if (tl) { LAS float* tr = tab + (kr - r_w + 7) * 31; \
                        _Pragma("unroll") for (int e = 0; e < 8; ++e) { const int x = (e >> 2) * 16 + (e & 3); const bool valid = (unsigned)(rel + x) < 16u; int dc = dcb + x; dc = dc < 0 ? 0 : (dc > 30 ? 30 : dc); \
                            const float sv = (e < 4 ? s0[e & 3] : s1[e & 3]) * C1 + tr[dc]; tv[e] = valid ? sv : -1e30f; tmax = fmaxf(tmax, tv[e]); } } \
                    else { \
                        _Pragma("unroll") for (int e = 0; e < 8; ++e) { tv[e] = (e < 4 ? s0[e & 3] : s1[e & 3]) * C1; tmax = fmaxf(tmax, tv[e]); } } \
                    tmax = fmaxf(tmax, __shfl_xor(tmax, 16)); tmax = fmaxf(tmax, __shfl_xor(tmax, 32)); \
                    const float mn = fmaxf(m, tmax); \
                    if (!__all(mn == m)) { const float al = __builtin_amdgcn_exp2f(m - mn); lsum *= al; \
                        _Pragma("unroll") for (int dt = 0; dt < 8; ++dt) o[dt] = o[dt] * al; } \
                    m = mn; \
                    float p[8]; \
                    _Pragma("unroll") for (int e = 0; e < 8; ++e) { p[e] = tv[e] > -1e29f ? __builtin_amdgcn_exp2f(tv[e] - m) : 0.f; lsum += p[e]; } \
                    union { att_s8 v; unsigned w[4]; } pf; \
                    pf.w[0] = pg8::cvt_pk_bf16(p[0], p[1]); pf.w[1] = pg8::cvt_pk_bf16(p[2], p[3]); pf.w[2] = pg8::cvt_pk_bf16(p[4], p[5]); pf.w[3] = pg8::cvt_pk_bf16(p[6], p[7]); \
                    { const int swv = 4 * (g & 1) + (i16 >> 2); LAS unsigned char* vp = kb + 16384 + (koff + 4 * g + (i16 >> 2)) * 256 + (i16 & 3) * 8; \
                      _Pragma("unroll") for (int dt = 0; dt < 8; ++dt) { const int off = (dt ^ swv) * 32; \
                          const att_s4 va = __builtin_amdgcn_ds_read_tr16_b64_v4i16((LAS att_s4*)(vp + off)), vb = __builtin_amdgcn_ds_read_tr16_b64_v4i16((LAS att_s4*)(vp + 4096 + off)); \
                          const att_s8 vf = __builtin_shufflevector(va, vb, 0, 1, 2, 3, 4, 5, 6, 7); \
                          o[dt] = __builtin_amdgcn_mfma_f32_16x16x32_bf16(vf, pf.v, o[dt], 0, 0, 0); } } \
                } \
            } } while (0)
#define ATT_STEP(t, sfree, snext) do { { const int tq_ = (t) + 3 < ntiles ? (t) + 3 : ntiles - 1; ATT_LOAD(tq_, sfree); } if ((t) < ntiles) ATT_COMPUTE(t); ATT_WRITE(((t) + 1) & 1, snext); __syncthreads(); } while (0)
        { ATT_LOAD(0, stgA); const int t1_ = 1 < ntiles ? 1 : ntiles - 1, t2_ = 2 < ntiles ? 2 : ntiles - 1; ATT_LOAD(t1_, stgB); ATT_LOAD(t2_, stgC); }
        ATT_WRITE(0, stgA);
        __syncthreads();
        for (int t = 0; t < ntiles; t += 3) {
            ATT_STEP(t, stgA, stgB);
            ATT_STEP(t + 1, stgB, stgC);
            ATT_STEP(t + 2, stgC, stgA);
        }
#undef ATT_STEP
#undef ATT_COMPUTE
#undef ATT_ROW0
#undef ATT_LOAD
#undef ATT_WRITE
        lsum += __shfl_xor(lsum, 16); lsum += __shfl_xor(lsum, 32);
        const float inv = 1.0f / lsum;
        bf16* op = O + (size_t)qrow * D + h * HD + 4 * g;
#pragma unroll
        for (int dt = 0; dt < 8; ++dt) { v2u w; w.x = pg8::cvt_pk_bf16(o[dt][0] * inv, o[dt][1] * inv); w.y = pg8::cvt_pk_bf16(o[dt][2] * inv, o[dt][3] * inv); *(v2u*)(op + 16 * dt) = w; }
    }
    __syncthreads();
}

constexpr int NPHASE = 3 + 7 * DEPTH;
__global__ void __launch_bounds__(NWAVES * 64, 2) fwd(Args args) {
    extern __shared__ __attribute__((aligned(16))) unsigned char lds[];
    Frame F;
    F.lds = (LAS unsigned char*)lds;
    F.MISC = (volatile LAS unsigned*)(F.lds + MISC_OFF);
    F.tid = threadIdx.x; F.lane = F.tid & 63; F.wave = __builtin_amdgcn_readfirstlane(F.tid >> 6);
    F.G = gridDim.x; { const int bx = blockIdx.x; F.vcu = (F.G % 8 == 0) ? (bx % 8) * (F.G / 8) + bx / 8 : bx; }
    unsigned char* ws = args.ws;
    F.ctl = (gu32*)(ws + WS_CTL);
    for (int u = F.tid; u < (LDS_BYTES - LDSCTL_OFF) / 4; u += NWAVES * 64) ((LAS unsigned*)(F.lds + LDSCTL_OFF))[u] = 0u;
    __syncthreads();
    const int lo = args.ph_lo, hi = args.ph_hi;
    const bool multi = (hi - lo) > 1;
    XcdBarrier bar; bar.bar = (unsigned*)(F.ctl + CW_BAR); bar.x = 0; bar.st = nullptr;
    if (multi) bar = xcd_barrier_post((unsigned*)(F.ctl + CW_BAR), F.MISC + 8);
#define IN(k) (lo <= (k) && (k) < hi)
#define SEAM(k) do { if (IN((k) + 1)) xcd_barrier(bar); } while (0)

    float* const X = (float*)(ws + WS_X);
    const float* const ADA = (const float*)(ws + WS_ADA);
    bf16* const H = (bf16*)(ws + WS_H);

#ifndef PROBE_ID
#define PROBE_ID 0
#endif
#define NREP(id) ((PROBE_ID) == (id) ? 2 : 1)
    float* const XDUM = (float*)(ws + WS_DUMX); bf16* const HDUM = (bf16*)(ws + WS_DUMH);
    if (IN(0)) { for (int rep = 0; rep < NREP(1); ++rep) { p_ada_partial(F, args); __syncthreads(); p_convert_weights(F, args); } SEAM(0); }
    if (IN(1)) { p_ada_reduce(F, args); SEAM(1); }
    if (IN(2)) { p_modulate(F, args, MR, ADA, 0, D); SEAM(2); }

    for (int l = 0; l < DEPTH; ++l) {
        const int pb = 3 + 7 * l;
        const bool use_na = (l & 1) == 0; const int j = l >> 1;
        const int rows = l < 2 ? MR : ML;
        const float* ada_l = ADA + (size_t)l * NCOND * ADAW;
        if (use_na) {
            if (IN(pb + 0)) {
                for (int rep = 0; rep < NREP(2); ++rep) {
                pg8::Gemm g{H, (const bf16*)(ws + WS_WQKV) + (size_t)j * 3 * D * D, MR, 3 * D, D, D, D, 0, 0}; pg8::StaticOrder S; S.init(MR, 3 * D, pg8::opaque_s(F.G), pg8::opaque_s((int)blockIdx.x));
                pg8::EpiBf16 E{(bf16*)(ws + WS_QKV), 3 * D};
                pg8::gemm_phase<pg8::EpiBf16, pg8::StaticOrder, true, true>(F.lds + RING_OFF, g, S, E); }
                SEAM(pb + 0);
            }
            if (IN(pb + 1)) { for (int rep = 0; rep < NREP(3); ++rep) p_attention_mfma(F, args, args.na_rpb + (size_t)j * NH * 15 * 31, l == 0); SEAM(pb + 1); }
        } else {
            if (IN(pb + 0)) { for (int rep = 0; rep < NREP(4); ++rep) p_pool(F, args, rows, ada_l); SEAM(pb + 0); }
        }
        float* const PARTC = (float*)(ws + WS_PART);
        const bool ctx_split_mix = (l == 0);
        const bool ctx_split_ffn = (l < 2);
        const float* gate_ctx = ada_l + (size_t)BATCH * ADAW;
        if (IN(pb + 2)) {
            for (int rep = 0; rep < NREP(5); ++rep) {
            const int mrows = use_na ? ML : rows;
            pg8::Gemm g; pg8::EpiRes E{l == 0 ? args.x : X, rep == NREP(5) - 1 ? X : XDUM, D, ada_l + 2 * D, ADAW, nullptr, DN_ALPHA};
            if (use_na) g = pg8::Gemm{(const bf16*)(ws + WS_O), (const bf16*)(ws + WS_WO) + (size_t)j * D * D, mrows, D, D, D, D, 0, 0};
            else { g = pg8::Gemm{(const bf16*)(ws + WS_O), (const bf16*)(ws + WS_WPOOL) + (size_t)j * D * 512, mrows, D, 512, D, 512, 2, 512}; E.colscale = args.pool_scale + (size_t)j * D; }
            pg8::StaticOrder S; S.init(mrows, D, pg8::opaque_s(F.G), pg8::opaque_s((int)blockIdx.x));
            pg8::gemm_phase<pg8::EpiRes, pg8::StaticOrder, true, true>(F.lds + RING_OFF, g, S, E);
            if (ctx_split_mix) {
                pg8::Gemm gc{(const bf16*)(ws + WS_O), (const bf16*)(ws + WS_WO) + (size_t)j * D * D, MR, D, D / 4, D, D, 0, 0}; pg8::SplitOrder Sc; Sc.init(ML / 256, MC / 256, D / 256, 4, pg8::opaque_s(F.G), pg8::opaque_s((int)blockIdx.x));
                pg8::EpiPart Ec{PARTC, D, ML / 256, (size_t)MC * D};
                pg8::gemm_phase<pg8::EpiPart, pg8::SplitOrder, true, true>(F.lds + RING_OFF, gc, Sc, Ec); } }
            SEAM(pb + 2);
        }
        if (IN(pb + 3)) { for (int rep = 0; rep < NREP(6); ++rep) { const bool fin = rep == NREP(6) - 1;
            p_layernorm(F, args, rows, args.ln_mix_g + (size_t)l * D, args.ln_mix_b + (size_t)l * D, fin ? X : XDUM, fin ? H : HDUM, ada_l, 3 * D, 4 * D, ctx_split_mix ? PARTC : nullptr, gate_ctx + 2 * D, l == 0 ? args.ctx : nullptr); } SEAM(pb + 3); }
        if (IN(pb + 4)) {
            for (int rep = 0; rep < NREP(7); ++rep) {
            pg8::Gemm g{H, (const bf16*)(ws + WS_WIN) + (size_t)l * 2 * DFF * D, rows, 2 * DFF, D, D, D, 0, 0}; pg8::StaticOrder S; S.init(rows, 2 * DFF, pg8::opaque_s(F.G), pg8::opaque_s((int)blockIdx.x));
            pg8::EpiSwiGLU E{(bf16*)(ws + WS_ACT), DFF};
            pg8::gemm_phase<pg8::EpiSwiGLU, pg8::StaticOrder, true, true>(F.lds + RING_OFF, g, S, E); }
            SEAM(pb + 4);
        }
        if (IN(pb + 5)) {
            for (int rep = 0; rep < NREP(8); ++rep) {
            pg8::Gemm g{(const bf16*)(ws + WS_ACT), (const bf16*)(ws + WS_WOUT) + (size_t)l * D * DFF, ML, D, DFF, DFF, DFF, 0, 0}; pg8::StaticOrder S; S.init(ML, D, pg8::opaque_s(F.G), pg8::opaque_s((int)blockIdx.x)); S.rowmajor = 1;
            pg8::EpiRes E{X, rep == NREP(8) - 1 ? X : XDUM, D, ada_l + 5 * D, ADAW, nullptr, DN_ALPHA};
            pg8::gemm_phase<pg8::EpiRes, pg8::StaticOrder, true, true>(F.lds + RING_OFF, g, S, E);
            if (ctx_split_ffn) {
                pg8::Gemm gc{(const bf16*)(ws + WS_ACT), (const bf16*)(ws + WS_WOUT) + (size_t)l * D * DFF, MR, D, DFF / 4, DFF, DFF, 0, 0}; pg8::SplitOrder Sc; Sc.init(ML / 256, MC / 256, D / 256, 4, pg8::opaque_s(F.G), pg8::opaque_s((int)blockIdx.x));
                pg8::EpiPart Ec{PARTC, D, ML / 256, (size_t)MC * D};
                pg8::gemm_phase<pg8::EpiPart, pg8::SplitOrder, true, true>(F.lds + RING_OFF, gc, Sc, Ec); } }
            SEAM(pb + 5);
        }
        if (IN(pb + 6)) {
            const bool last = (l == DEPTH - 1);
            const int nrows = l < 2 ? MR : ML;
            for (int rep = 0; rep < NREP(6); ++rep) { const bool fin = rep == NREP(6) - 1;
            p_layernorm(F, args, nrows, args.ln_ffn_g + (size_t)l * D, args.ln_ffn_b + (size_t)l * D, fin ? (last ? args.out : X) : XDUM, fin ? H : HDUM, last ? nullptr : ada_l + (size_t)NCOND * ADAW, 0, D,
                        ctx_split_ffn ? PARTC : nullptr, gate_ctx + 5 * D, nullptr); }
            if (!last) SEAM(pb + 6);
        }
    }
#undef IN
#undef SEAM
}

extern "C" void kernel_launch(void* const* d_in, const int* in_sizes, int n_in, void* d_out, int out_size, void* d_ws, size_t ws_size, hipStream_t stream) {
    static int grid = 0;
    if (grid == 0) {
        if (n_in != 17 || out_size != ML * D || ws_size < WS_END) { fprintf(stderr, "kernel_launch: unexpected shapes (n_in %d, out %d, ws %zu); nothing launched\n", n_in, out_size, ws_size); grid = -1; return; }
        int dev = 0, cus = 0, per_cu = 0;
        if (hipGetDevice(&dev) != hipSuccess || hipDeviceGetAttribute(&cus, hipDeviceAttributeMultiprocessorCount, dev) != hipSuccess) { grid = -1; return; }
        if (hipFuncSetAttribute((const void*)fwd, hipFuncAttributeMaxDynamicSharedMemorySize, LDS_BYTES) != hipSuccess) { fprintf(stderr, "kernel_launch: hipFuncSetAttribute failed\n"); grid = -1; return; }
        if (hipOccupancyMaxActiveBlocksPerMultiprocessor(&per_cu, (const void*)fwd, NWAVES * 64, LDS_BYTES) != hipSuccess || per_cu < 1)
            fprintf(stderr, "kernel_launch: note: occupancy query reports %d workgroups per CU\n", per_cu);
        (void)hipGetLastError();
        grid = cus;
    }
    if (grid < 0) return;
    if (hipMemsetAsync((char*)d_ws + WS_CTL, 0, CTL_ZERO_BYTES, stream) != hipSuccess) { fprintf(stderr, "kernel_launch: memset failed\n"); return; }
    Args a{};
    a.x = (const float*)d_in[0]; a.c = (const float*)d_in[1]; a.ctx = (const float*)d_in[2]; a.c_ctx = (const float*)d_in[3]; a.ada_w = (const float*)d_in[4]; a.ada_b = (const float*)d_in[5];
    a.ln_mix_g = (const float*)d_in[6]; a.ln_mix_b = (const float*)d_in[7]; a.ln_ffn_g = (const float*)d_in[8]; a.ln_ffn_b = (const float*)d_in[9];
    a.na_w_qkv = (const float*)d_in[10]; a.na_w_o = (const float*)d_in[11]; a.na_rpb = (const float*)d_in[12]; a.pool_w = (const float*)d_in[13]; a.pool_scale = (const float*)d_in[14];
    a.ffn_w_in = (const float*)d_in[15]; a.ffn_w_out = (const float*)d_in[16];
    a.out = (float*)d_out; a.ws = (unsigned char*)d_ws;
#if MK_ONE_LAUNCH
    a.ph_lo = 0; a.ph_hi = NPHASE;
    hipLaunchKernelGGL(fwd, dim3(grid), dim3(NWAVES * 64), LDS_BYTES, stream, a);
#else
    for (int p = 0; p < NPHASE; ++p) {
        const int l = (p - 3) / 7, s = (p - 3) % 7;
        if (p >= 3 && (l & 1) == 1 && s == 1) continue;
        a.ph_lo = p; a.ph_hi = p + 1;
        hipLaunchKernelGGL(fwd, dim3(grid), dim3(NWAVES * 64), LDS_BYTES, stream, a);
    }
#endif
    const hipError_t le = hipPeekAtLastError();
    if (le != hipSuccess) fprintf(stderr, "kernel_launch: launch failed: %s\n", hipGetErrorName(le));
}
```
